# Optimizing an MI355X kernel written in HIP

```python
import math
import jax
import jax.numpy as jnp
from jax import lax
import numpy as np

D_MODEL = 1024
BATCH = 4
SEQ = 4096
DEPTH = 2

GRID_W = 64
CTX_LEN = 256
N_BRANCH = 4
W_BR = 256
N_MOD = 6
NORM_EPS = 1e-6
F32 = jnp.float32

HY_SHORT = 3
HY_BANDS = 8
HY_EMB = 2 * HY_BANDS + 1
HY_HID = 64
HY_TARGET = 1e-2
HY_FAST_PCT = 0.3
HY_SLOW_PCT = 1.5

S5_GROUP = 16
S5_GROUPS = W_BR // S5_GROUP
S5_STATE = 64

RW_HEAD = 64
RW_HEADS = W_BR // RW_HEAD
RW_W_RANK = 32
RW_A_RANK = 32
RW_G_RANK = 64
RW_GN_EPS = 64e-5

M2_HEADDIM = 64
M2_HEADS = W_BR // M2_HEADDIM
M2_GROUPS = 2
M2_STATE = 128
M2_CONV = 3

MOE_GROUPS = 4
MOE_PER_GROUP = 4
MOE_EXPERTS = MOE_GROUPS * MOE_PER_GROUP
MOE_TOPK = 2
MOE_FF = 512

HY_COLS = 3 * W_BR
S5_COLS = W_BR
RW_COLS = 3 * W_BR + 2 * RW_W_RANK + 2 * RW_A_RANK + RW_G_RANK
M2_XBC = W_BR + 2 * M2_GROUPS * M2_STATE
M2_COLS = W_BR + M2_XBC + 2 * M2_HEADS
GATE_COLS = N_BRANCH * D_MODEL
IN_COLS = HY_COLS + S5_COLS + RW_COLS + M2_COLS + GATE_COLS

kernel_name = 'hybrid_parallel_mixers_hmoe_dit'


def _split(x, sizes):
    idx = [int(i) for i in np.cumsum(sizes)[:-1]]
    return jnp.split(x, idx, axis=-1)


def rmsnorm(x, g):
    xf = x.astype(F32)
    xf = xf * lax.rsqrt(jnp.mean(xf * xf, axis=-1, keepdims=True) + NORM_EPS)
    return xf.astype(x.dtype) * g


def modulate(x, g, shift, scale):
    return rmsnorm(x, g) * (1 + scale) + shift


def centred_conv(x, w, b):
    k = w.shape[0]
    pad = k // 2
    L = x.shape[1]
    xp = jnp.pad(x, ((0, 0), (pad, pad), (0, 0)))
    y = b
    for j in range(k):
        y = y + xp[:, j:j + L] * w[j]
    return y


def centred_shift(x):
    xp = jnp.pad(x, ((0, 0), (1, 1), (0, 0)))
    return 0.5 * (xp[:, :-2] + xp[:, 2:])


def hyena_filters(L, w1, b1, w2, b2, w3, freq):
    t = jnp.linspace(0.0, 1.0, L, dtype=F32)[:, None]
    w = 2.0 * math.pi * jnp.arange(L, dtype=F32)[:, None] / L
    f = jnp.linspace(1e-4, HY_BANDS - 1, HY_BANDS, dtype=F32)[None, :]
    feats = jnp.concatenate([t, jnp.cos(f * w), -jnp.sin(f * w)], axis=-1)
    fr = freq.astype(F32)
    h = jnp.sin(fr * (feats @ w1.astype(F32) + b1.astype(F32)))
    h = jnp.sin(fr * (h @ w2.astype(F32) + b2.astype(F32)))
    h = h @ w3.astype(F32)
    deltas = jnp.abs(jnp.linspace(math.log(HY_TARGET) / HY_SLOW_PCT,
                                  math.log(HY_TARGET) / HY_FAST_PCT, W_BR, dtype=F32))
    decay = jnp.exp(-t * deltas)
    return h * jnp.concatenate([decay, decay], axis=-1)


def hyena_mixer(p, conv_w, conv_b, f_w1, f_b1, f_w2, f_b2, f_w3, f_freq, h_bias):
    L = p.shape[1]
    x0, x1, v = jnp.split(centred_conv(p, conv_w, conv_b), 3, axis=-1)
    filt = hyena_filters(L, f_w1, f_b1, f_w2, f_b2, f_w3, f_freq)
    h_f, h_b = filt[:, :W_BR], filt[:, W_BR:]
    filt_full = jnp.concatenate([h_f, jnp.zeros((1, W_BR), F32), h_b[:0:-1]], axis=0)
    u = (x1 * v).astype(F32)
    n = 2 * L
    y = jnp.fft.irfft(jnp.fft.rfft(u, n=n, axis=1) * jnp.fft.rfft(filt_full, axis=0)[None],
                      n=n, axis=1)[:, :L]
    y = y + h_bias.astype(F32) * u
    return x0 * y.astype(p.dtype)


def _lin_rec(e1, e2):
    a1, b1 = e1
    a2, b2 = e2
    return a1 * a2, a2 * b1 + b2


def s5_mixer(u, h0, lam_re, lam_im, log_step, b_re, b_im, c_re, c_im, d_skip, w_glu):
    b_, L, _ = u.shape
    uc = u.astype(F32).reshape(b_, L, S5_GROUPS, S5_GROUP).astype(jnp.complex64)
    y = d_skip * u
    finals = []
    for d in range(2):
        lam = lax.complex(lam_re[d].astype(F32), lam_im[d].astype(F32))
        lam_bar = jnp.exp(lam * jnp.exp(log_step[d].astype(F32))[:, None])
        b_bar = ((lam_bar - 1.0) / lam)[:, :, None] * lax.complex(b_re[d].astype(F32), b_im[d].astype(F32))
        seq = uc if d == 0 else jnp.flip(uc, 1)
        bu = jnp.einsum('blgi,gni->blgn', seq, b_bar)
        bu = bu.at[:, 0].add(lam_bar * h0[d])
        _, xs = lax.associative_scan(_lin_rec, (jnp.broadcast_to(lam_bar, bu.shape), bu), axis=1)
        finals.append(xs[:, -1])
        yd = jnp.einsum('blgn,gin->blgi', xs,
                        lax.complex(c_re[d].astype(F32), c_im[d].astype(F32))).real
        if d == 1:
            yd = jnp.flip(yd, 1)
        y = y + yd.reshape(b_, L, W_BR).astype(u.dtype)
    y = jax.nn.gelu(y)
    return y * jax.nn.sigmoid(y @ w_glu), jnp.stack(finals)


def wkv7(r, w, k, v, kk, a, s0, reverse):
    def step(s, inp):
        r_t, w_t, k_t, v_t, kk_t, a_t = inp
        sa = jnp.einsum('bhvk,bhk->bhv', s, kk_t)
        s = (s * w_t[:, :, None, :] - sa[..., None] * (kk_t * a_t)[:, :, None, :]
             + v_t[..., None] * k_t[:, :, None, :])
        return s, jnp.einsum('bhvk,bhk->bhv', s, r_t)
    xs = tuple(jnp.moveaxis(t, 1, 0) for t in (r, w, k, v, kk, a))
    s_final, y = lax.scan(step, s0, xs, reverse=reverse)
    return jnp.moveaxis(y, 0, 1), s_final


def rwkv_mixer(p, s0, mu, w0, w2, a0, a2, g2, k_k, k_a, r_k, ln_w, ln_b):
    out_dtype = p.dtype
    b_, L, _ = p.shape
    p = (p + (centred_shift(p) - p) * mu).astype(F32)
    r, k, v, wd, ad, gd = _split(p, [W_BR, W_BR, W_BR, 2 * RW_W_RANK, 2 * RW_A_RANK, RW_G_RANK])
    heads = lambda t: t.reshape(b_, L, RW_HEADS, RW_HEAD)
    g = jax.nn.sigmoid(gd) @ g2.astype(F32)
    kk = heads(k * k_k)
    kk = kk * lax.rsqrt(jnp.maximum(jnp.sum(kk * kk, -1, keepdims=True), 1e-24))
    rh, kh, vh = heads(r), heads(k), heads(v)
    y = None
    finals = []
    for d in range(2):
        w = w0[d] + jnp.tanh(wd[..., d * RW_W_RANK:(d + 1) * RW_W_RANK]) @ w2[d].astype(F32)
        decay = jnp.exp(-jnp.exp(-jax.nn.softplus(-w) - 0.5))
        a = jax.nn.sigmoid(a0[d] + ad[..., d * RW_A_RANK:(d + 1) * RW_A_RANK] @ a2[d].astype(F32))
        kd = heads(k * (1 + (a - 1) * k_a))
        yd, sf = wkv7(rh, heads(decay), kd, vh, kk, heads(a), s0[d], d == 1)
        y = yd if d == 0 else y + yd
        finals.append(sf)
    mean = jnp.mean(y, -1, keepdims=True)
    var = jnp.mean(jnp.square(y - mean), -1, keepdims=True)
    y = ((y - mean) * lax.rsqrt(var + RW_GN_EPS)).reshape(b_, L, W_BR) * ln_w + ln_b
    bonus = jnp.sum(rh * kh * r_k, -1, keepdims=True) * vh
    y = (y + bonus.reshape(b_, L, W_BR)) * g
    return y.astype(out_dtype), jnp.stack(finals)


def ssd_scan(xh, dt, a, bm, cm, h0, n_chunks):
    b_, L, H, P = xh.shape
    q = L // n_chunks
    rep = H // M2_GROUPS
    bh = jnp.repeat(bm, rep, axis=2).reshape(b_, n_chunks, q, H, M2_STATE)
    ch = jnp.repeat(cm, rep, axis=2).reshape(b_, n_chunks, q, H, M2_STATE)
    xdt = (xh * dt[..., None]).reshape(b_, n_chunks, q, H, P)
    acs = jnp.cumsum((dt * a).reshape(b_, n_chunks, q, H), axis=2)
    lower = jnp.tril(jnp.ones((q, q), bool))[None, None, :, :, None]
    seg = acs[:, :, :, None, :] - acs[:, :, None, :, :]
    decay_in = jnp.exp(jnp.where(lower, seg, -jnp.inf))
    scores = jnp.einsum('bcihn,bcjhn->bcijh', ch, bh) * decay_in
    y_diag = jnp.einsum('bcijh,bcjhp->bcihp', scores, xdt)
    decay_out = jnp.exp(acs[:, :, -1:, :] - acs)
    states = jnp.einsum('bcjhn,bcjh,bcjhp->bchpn', bh, decay_out, xdt)
    chunk_decay = jnp.exp(acs[:, :, -1, :])

    def step(h, inp):
        st, dec = inp
        return h * dec[:, :, None, None] + st, h

    h_final, h_enter = lax.scan(step, h0, (jnp.moveaxis(states, 1, 0), jnp.moveaxis(chunk_decay, 1, 0)))
    h_enter = jnp.moveaxis(h_enter, 0, 1)
    y_off = jnp.einsum('bcihn,bchpn,bcih->bcihp', ch, h_enter, jnp.exp(acs))
    return (y_diag + y_off).reshape(b_, L, H, P), h_final


def mamba_mixer(p, h0, n_chunks, conv_w, conv_b, a_log, dt_bias, d_skip, norm_w):
    b_, L, _ = p.shape
    z, xbc, dt = _split(p, [W_BR, M2_XBC, 2 * M2_HEADS])
    xbc = jax.nn.silu(centred_conv(xbc, conv_w, conv_b)).astype(F32)
    xs, bm, cm = _split(xbc, [W_BR, M2_GROUPS * M2_STATE, M2_GROUPS * M2_STATE])
    xh = xs.reshape(b_, L, M2_HEADS, M2_HEADDIM)
    bm = bm.reshape(b_, L, M2_GROUPS, M2_STATE)
    cm = cm.reshape(b_, L, M2_GROUPS, M2_STATE)
    y = d_skip.astype(F32)[:, None] * xh
    finals = []
    for d in range(2):
        dtd = jax.nn.softplus(dt[..., d * M2_HEADS:(d + 1) * M2_HEADS].astype(F32) + dt_bias[d].astype(F32))
        a = -jnp.exp(a_log[d].astype(F32))
        seqs = (xh, dtd, bm, cm) if d == 0 else tuple(jnp.flip(t, 1) for t in (xh, dtd, bm, cm))
        yd, hf = ssd_scan(seqs[0], seqs[1], a, seqs[2], seqs[3], h0[d], n_chunks)
        y = y + (yd if d == 0 else jnp.flip(yd, 1))
        finals.append(hf)
    y = y.reshape(b_, L, W_BR).astype(p.dtype) * jax.nn.silu(z)
    return rmsnorm(y, norm_w), jnp.stack(finals)


def merge(ys, gate_cols, w_branch, w_out):
    gates = jax.nn.sigmoid(gate_cols)
    out = sum(gates[..., i * D_MODEL:(i + 1) * D_MODEL] * (ys[i] @ w_branch[i]) for i in range(N_BRANCH))
    return out @ w_out


def moe_ffn(u, w_group, w_expert, w_gate, w_up, w_down):
    uf = u.astype(F32)
    grp_prob = jax.nn.softmax(uf @ w_group.astype(F32), axis=-1)
    grp_p, grp_idx = lax.top_k(grp_prob, 1)
    exp_logits = jnp.einsum('bld,gde->blge', uf, w_expert.astype(F32))
    sel = jnp.einsum('blge,blg->ble', exp_logits, jax.nn.one_hot(grp_idx[..., 0], MOE_GROUPS, dtype=F32))
    top_v, top_i = lax.top_k(sel, MOE_TOPK)
    top_w = jax.nn.softmax(top_v, axis=-1) * grp_p
    e_idx = grp_idx * MOE_PER_GROUP + top_i
    comb = jnp.sum(jax.nn.one_hot(e_idx, MOE_EXPERTS, dtype=F32) * top_w[..., None], axis=-2).astype(u.dtype)
    y = jnp.zeros_like(u)
    for e in range(MOE_EXPERTS):
        h = jax.nn.silu(u @ w_gate[e]) * (u @ w_up[e])
        y = y + comb[..., e:e + 1] * (h @ w_down[e])
    return y


def hybrid_layer(x, cx, c, c_ctx, mod_w, mod_b, norm_mix, norm_ffn, w_in, hy, s5, rw, m2,
                 w_branch, w_out, moe, rows, ctx_rows, ctx_out):
    mod_x = jax.nn.silu(c) @ mod_w + mod_b
    mod_c = jax.nn.silu(c_ctx) @ mod_w + mod_b
    sh1, sc1, g1, sh2, sc2, g2 = jnp.split(mod_x[:, None, :], N_MOD, axis=-1)
    csh1, csc1, cg1, csh2, csc2, cg2 = jnp.split(mod_c, N_MOD, axis=-1)

    px = modulate(x, norm_mix, sh1, sc1) @ w_in
    pc = modulate(cx, norm_mix, csh1, csc1) @ w_in
    sizes = [HY_COLS, S5_COLS, RW_COLS, M2_COLS, GATE_COLS]
    hy_x, s5_x, rw_x, m2_x, gate_x = _split(px, sizes)
    hy_c, s5_c, rw_c, m2_c, gate_c = _split(pc, sizes)

    b_ = x.shape[0]
    s5_0 = jnp.zeros((2, b_, S5_GROUPS, S5_STATE), jnp.complex64)
    rw_0 = jnp.zeros((2, b_, RW_HEADS, RW_HEAD, RW_HEAD), F32)
    m2_0 = jnp.zeros((2, b_, M2_HEADS, M2_HEADDIM, M2_STATE), F32)

    y_s5c, s5_h = s5_mixer(s5_c, s5_0, *s5)
    y_rwc, rw_h = rwkv_mixer(rw_c, rw_0, *rw)
    y_m2c, m2_h = mamba_mixer(m2_c, m2_0, ctx_rows, *m2)

    ys_x = [hyena_mixer(hy_x, *hy),
            s5_mixer(s5_x, s5_h, *s5)[0],
            rwkv_mixer(rw_x, rw_h, *rw)[0],
            mamba_mixer(m2_x, m2_h, rows, *m2)[0]]
    x = x + g1 * merge(ys_x, gate_x, w_branch, w_out)
    x = x + g2 * moe_ffn(modulate(x, norm_ffn, sh2, sc2), *moe)

    if ctx_out:
        ys_c = [hyena_mixer(hy_c, *hy), y_s5c, y_rwc, y_m2c]
        cx = cx + cg1 * merge(ys_c, gate_c, w_branch, w_out)
        cx = cx + cg2 * moe_ffn(modulate(cx, norm_ffn, csh2, csc2), *moe)
    return x, cx


def setup_inputs(seed: int = 0) -> dict:
    key = jax.random.key(seed)
    ks = iter(jax.random.split(key, 64))
    nrm = lambda shape, s=1.0: s * jax.random.normal(next(ks), shape, F32)
    uni = lambda shape, lo, hi: jax.random.uniform(next(ks), shape, F32, lo, hi)
    Ld = DEPTH
    inp = {}
    inp['x'] = nrm((BATCH, SEQ, D_MODEL))
    inp['c'] = nrm((BATCH, D_MODEL))
    inp['ctx'] = nrm((BATCH, CTX_LEN, D_MODEL))
    inp['c_ctx'] = nrm((D_MODEL,))
    inp['mod_w'] = nrm((Ld, D_MODEL, N_MOD * D_MODEL), 0.02)
    inp['mod_b'] = nrm((Ld, N_MOD * D_MODEL), 0.02)
    inp['norm_mix'] = 1.0 + nrm((Ld, D_MODEL), 0.02)
    inp['norm_ffn'] = 1.0 + nrm((Ld, D_MODEL), 0.02)
    inp['w_in'] = nrm((Ld, D_MODEL, IN_COLS), D_MODEL ** -0.5)
    inp['hy_conv_w'] = nrm((Ld, HY_SHORT, HY_COLS), 0.5)
    inp['hy_conv_b'] = nrm((Ld, HY_COLS), 0.02)
    inp['hy_f_w1'] = nrm((Ld, HY_EMB, HY_HID), HY_EMB ** -0.5)
    inp['hy_f_b1'] = nrm((Ld, HY_HID), 0.1)
    inp['hy_f_w2'] = nrm((Ld, HY_HID, HY_HID), HY_HID ** -0.5)
    inp['hy_f_b2'] = nrm((Ld, HY_HID), 0.1)
    inp['hy_f_w3'] = nrm((Ld, HY_HID, 2 * W_BR), 0.02)
    inp['hy_f_freq'] = 1.0 + nrm((Ld, HY_HID), 0.1)
    inp['hy_bias'] = nrm((Ld, W_BR), 0.5)
    inp['s5_lam_re'] = -0.5 + nrm((Ld, 2, S5_GROUPS, S5_STATE), 0.01)
    inp['s5_lam_im'] = math.pi * jnp.arange(S5_STATE, dtype=F32) + nrm((Ld, 2, S5_GROUPS, S5_STATE), 0.01)
    inp['s5_log_step'] = uni((Ld, 2, S5_GROUPS), math.log(1e-3), math.log(1e-1))
    inp['s5_b_re'] = nrm((Ld, 2, S5_GROUPS, S5_STATE, S5_GROUP), (2 * S5_GROUP) ** -0.5)
    inp['s5_b_im'] = nrm((Ld, 2, S5_GROUPS, S5_STATE, S5_GROUP), (2 * S5_GROUP) ** -0.5)
    inp['s5_c_re'] = nrm((Ld, 2, S5_GROUPS, S5_GROUP, S5_STATE), S5_STATE ** -0.5)
    inp['s5_c_im'] = nrm((Ld, 2, S5_GROUPS, S5_GROUP, S5_STATE), S5_STATE ** -0.5)
    inp['s5_d'] = nrm((Ld, W_BR))
    inp['s5_w_glu'] = nrm((Ld, W_BR, W_BR), W_BR ** -0.5)
    ramp = jnp.arange(W_BR, dtype=F32) / (W_BR - 1)
    inp['rw_mu'] = uni((Ld, RW_COLS), 0.0, 1.0)
    inp['rw_w0'] = -6.0 + 5.0 * ramp ** 0.7 + nrm((Ld, 2, W_BR), 0.1)
    inp['rw_w2'] = nrm((Ld, 2, RW_W_RANK, W_BR), 0.1)
    inp['rw_a0'] = nrm((Ld, 2, W_BR), 0.1)
    inp['rw_a2'] = nrm((Ld, 2, RW_A_RANK, W_BR), 0.1)
    inp['rw_g2'] = nrm((Ld, RW_G_RANK, W_BR), RW_G_RANK ** -0.5)
    inp['rw_k_k'] = 0.85 + nrm((Ld, W_BR), 0.02)
    inp['rw_k_a'] = 1.0 + nrm((Ld, W_BR), 0.02)
    inp['rw_r_k'] = nrm((Ld, RW_HEADS, RW_HEAD), 0.1)
    inp['rw_ln_w'] = 1.0 + nrm((Ld, W_BR), 0.02)
    inp['rw_ln_b'] = nrm((Ld, W_BR), 0.02)
    inp['m2_conv_w'] = nrm((Ld, M2_CONV, M2_XBC), 0.5)
    inp['m2_conv_b'] = nrm((Ld, M2_XBC), 0.02)
    inp['m2_a_log'] = jnp.log(uni((Ld, 2, M2_HEADS), 1.0, 16.0))
    dt0 = jnp.exp(uni((Ld, 2, M2_HEADS), math.log(1e-3), math.log(1e-1)))
    inp['m2_dt_bias'] = dt0 + jnp.log(-jnp.expm1(-dt0))
    inp['m2_d'] = 1.0 + nrm((Ld, M2_HEADS), 0.1)
    inp['m2_norm_w'] = 1.0 + nrm((Ld, W_BR), 0.02)
    inp['w_branch'] = nrm((Ld, N_BRANCH, W_BR, D_MODEL), W_BR ** -0.5)
    inp['w_out'] = nrm((Ld, D_MODEL, D_MODEL), D_MODEL ** -0.5)
    inp['moe_w_group'] = nrm((Ld, D_MODEL, MOE_GROUPS), D_MODEL ** -0.5)
    inp['moe_w_expert'] = nrm((Ld, MOE_GROUPS, D_MODEL, MOE_PER_GROUP), D_MODEL ** -0.5)
    inp['moe_w_gate'] = nrm((Ld, MOE_EXPERTS, D_MODEL, MOE_FF), D_MODEL ** -0.5)
    inp['moe_w_up'] = nrm((Ld, MOE_EXPERTS, D_MODEL, MOE_FF), D_MODEL ** -0.5)
    inp['moe_w_down'] = nrm((Ld, MOE_EXPERTS, MOE_FF, D_MODEL), MOE_FF ** -0.5)
    inp['norm_final'] = 1.0 + nrm((D_MODEL,), 0.02)
    return inp


def reference(x, c, ctx, c_ctx, mod_w, mod_b, norm_mix, norm_ffn, w_in,
              hy_conv_w, hy_conv_b, hy_f_w1, hy_f_b1, hy_f_w2, hy_f_b2, hy_f_w3, hy_f_freq, hy_bias,
              s5_lam_re, s5_lam_im, s5_log_step, s5_b_re, s5_b_im, s5_c_re, s5_c_im, s5_d, s5_w_glu,
              rw_mu, rw_w0, rw_w2, rw_a0, rw_a2, rw_g2, rw_k_k, rw_k_a, rw_r_k, rw_ln_w, rw_ln_b,
              m2_conv_w, m2_conv_b, m2_a_log, m2_dt_bias, m2_d, m2_norm_w,
              w_branch, w_out,
              moe_w_group, moe_w_expert, moe_w_gate, moe_w_up, moe_w_down,
              norm_final):
    rows = x.shape[1] // GRID_W
    ctx_rows = ctx.shape[1] // GRID_W
    cx = ctx
    for l in range(DEPTH):
        hy = (hy_conv_w[l], hy_conv_b[l], hy_f_w1[l], hy_f_b1[l], hy_f_w2[l], hy_f_b2[l],
              hy_f_w3[l], hy_f_freq[l], hy_bias[l])
        s5 = (s5_lam_re[l], s5_lam_im[l], s5_log_step[l], s5_b_re[l], s5_b_im[l],
              s5_c_re[l], s5_c_im[l], s5_d[l], s5_w_glu[l])
        rw = (rw_mu[l], rw_w0[l], rw_w2[l], rw_a0[l], rw_a2[l], rw_g2[l], rw_k_k[l], rw_k_a[l],
              rw_r_k[l], rw_ln_w[l], rw_ln_b[l])
        m2 = (m2_conv_w[l], m2_conv_b[l], m2_a_log[l], m2_dt_bias[l], m2_d[l], m2_norm_w[l])
        moe = (moe_w_group[l], moe_w_expert[l], moe_w_gate[l], moe_w_up[l], moe_w_down[l])
        x, cx = hybrid_layer(x, cx, c, c_ctx, mod_w[l], mod_b[l], norm_mix[l], norm_ffn[l], w_in[l],
                             hy, s5, rw, m2, w_branch[l], w_out[l], moe, rows, ctx_rows, l < DEPTH - 1)
    return rmsnorm(x, norm_final)
```

```cpp
#ifdef CPU_EMU
#include "emu.h"
#else
#include <hip/hip_runtime.h>
#include <hip/hip_cooperative_groups.h>
namespace cg = cooperative_groups;
#endif
#include <stdint.h>
#include <stddef.h>

#ifndef CFG_BATCH
#define CFG_BATCH 4
#define CFG_SEQ 4096
#define CFG_CTX 256
#endif

constexpr int D = 1024;
constexpr int NB = CFG_BATCH;
constexpr int SEQ = CFG_SEQ;
constexpr int CTX = CFG_CTX;
constexpr int NX = NB * SEQ;
constexpr int NC = NB * CTX;
constexpr int T = NX + NC;
constexpr int NCH = T / 64;
constexpr int LC = SEQ / 64, CC = CTX / 64, CPB = LC + CC;
constexpr int NR = NB + 1;
constexpr int NP = 3200;
constexpr int IN_COLS = 7112;
constexpr int FFTN = 2 * SEQ;
constexpr int NTHREADS = 256;
static_assert(T % 128 == 0, "T must be a multiple of 128");
static_assert(SEQ % 64 == 0 && CTX % 64 == 0, "chunking");

constexpr int PC_HY = 0, PC_S5 = 768, PC_RW = 1024, PC_M2 = 2048;
constexpr int PC_RW_R = 1024, PC_RW_K = 1280, PC_RW_V = 1536, PC_RW_WD = 1792, PC_RW_AD = 1856, PC_RW_GD = 1920;
constexpr int PC_M2_Z = 2048, PC_M2_X = 2304, PC_M2_B = 2560, PC_M2_C = 2816, PC_M2_DT = 3072;

enum { I_X = 0, I_C, I_CTX, I_CCTX, I_MODW, I_MODB, I_NMIX, I_NFFN, I_WIN,
       I_HCW, I_HCB, I_HW1, I_HB1, I_HW2, I_HB2, I_HW3, I_HFREQ, I_HBIAS,
       I_SLR, I_SLI, I_SSTEP, I_SBR, I_SBI, I_SCR, I_SCI, I_SD, I_SGLU,
       I_RMU, I_RW0, I_RW2, I_RA0, I_RA2, I_RG2, I_RKK, I_RKA, I_RRK, I_RLNW, I_RLNB,
       I_MCW, I_MCB, I_MALOG, I_MDTB, I_MD, I_MNW,
       I_WBR, I_WOUT, I_MOEG, I_MOEE, I_MOEGATE, I_MOEUP, I_MOEDOWN, I_NFIN, N_IN };

typedef unsigned short bf16_t;
typedef short bf16x8 __attribute__((ext_vector_type(8)));
typedef float f32x4 __attribute__((ext_vector_type(4)));

#ifdef CPU_EMU
#define MFMA16(a, b, c) emu_mfma_16x16x32_bf16(a, b, c)
#else
#define MFMA16(a, b, c) __builtin_amdgcn_mfma_f32_16x16x32_bf16(a, b, c, 0, 0, 0)
#endif

__device__ __forceinline__ unsigned f2u(float f) { return __builtin_bit_cast(unsigned, f); }
__device__ __forceinline__ float u2f(unsigned u) { return __builtin_bit_cast(float, u); }
__device__ __forceinline__ float bf2f(bf16_t h) { return u2f(((unsigned)h) << 16); }
__device__ __forceinline__ bf16_t f2bf(float f) { unsigned u = f2u(f); u += 0x7fffu + ((u >> 16) & 1u); return (bf16_t)(u >> 16); }
__device__ __forceinline__ unsigned pack2(float a, float b) { return (unsigned)f2bf(a) | ((unsigned)f2bf(b) << 16); }
__device__ __forceinline__ float sigmoidf_(float x) { return 1.0f / (1.0f + __expf(-x)); }
__device__ __forceinline__ float siluf_(float x) { return x / (1.0f + __expf(-x)); }
__device__ __forceinline__ float softplusf_(float x) { return x > 20.f ? x : log1pf(__expf(x)); }

constexpr size_t al256(size_t x) { return (x + 255) & ~(size_t)255; }
constexpr size_t SZ_BAR = 16384;
constexpr size_t SZ_MODV = al256((size_t)2 * NR * 6 * D * 4);
constexpr size_t SZ_TW = al256((size_t)(FFTN / 2) * 8);
constexpr size_t SZ_CRES = al256((size_t)NC * D * 4);
constexpr size_t SZ_XN = al256((size_t)T * D * 2);
constexpr size_t SZ_P = al256((size_t)T * NP * 2);
constexpr size_t SZ_YS = al256((size_t)4 * T * 256 * 2);
constexpr size_t SZ_WTIN = al256((size_t)NP * D * 2);
constexpr size_t SZ_WTGATE = al256((size_t)4096 * D * 2);
constexpr size_t SZ_WTBR = al256((size_t)4 * D * 256 * 2);
constexpr size_t SZ_WTOUT = al256((size_t)D * D * 2);
constexpr size_t SZ_WTGLU = al256((size_t)256 * 256 * 2);
constexpr size_t SZ_H2 = al256((size_t)(SEQ + CTX) * 64 * 4);
constexpr size_t SZ_HSPEC = al256((size_t)256 * FFTN * 8);
constexpr size_t SZ_FC = al256((size_t)2 * 256 * CTX * 4);
constexpr size_t SZ_UT = al256((size_t)NB * 256 * SEQ * 4);
constexpr size_t SZ_UTC = al256((size_t)NB * 256 * CTX * 4);
constexpr int NCHP = ((NCH + 127) / 128) * 128;
constexpr size_t SZ_S5E = al256((size_t)2 * 16 * 65 * 64 * 8);
constexpr size_t SZ_S5BB = al256((size_t)2 * 16 * 64 * 16 * 8);
constexpr size_t SZ_S5KC = al256((size_t)16 * 127 * 256 * 2);
constexpr size_t SZ_S5PM = al256((size_t)16 * 256 * 1024 * 2);
constexpr size_t SZ_S5RM = al256((size_t)16 * 1024 * 256 * 2);
constexpr size_t SZ_S5ST = al256((size_t)16 * NCHP * 256 * 4);
constexpr size_t SZ_S5XE = al256((size_t)16 * NCHP * 256 * 2);
constexpr size_t SZ_S5Y1 = al256((size_t)T * 256 * 2);
constexpr size_t SZ_MST = al256((size_t)NCH * 4 * 2 * 64 * 128 * 2);
constexpr size_t SZ_MCD = al256((size_t)NCH * 8 * 4);
constexpr int RW_UNITS = NB * 2 * 4 * CPB;
constexpr size_t SZ_RP = al256((size_t)RW_UNITS * 4096 * 4);
constexpr size_t SZ_RQ = SZ_RP;
constexpr size_t SZ_WTGU = al256((size_t)16 * 1024 * 1024 * 2);
constexpr size_t SZ_WTDN = al256((size_t)16 * 1024 * 512 * 2);
constexpr size_t SZ_HB = al256((size_t)2 * T * 512 * 2);
constexpr size_t SZ_Y2 = al256((size_t)2 * T * D * 2);
constexpr size_t SZ_MERGED = al256((size_t)T * D * 2);
constexpr size_t SZ_LIST = al256((size_t)16 * T * 4);
constexpr size_t SZ_TOKINFO = al256((size_t)T * 4 * 4);
constexpr size_t SZ_CNT = 256;

constexpr size_t OFF_BAR = 0;
constexpr size_t OFF_MODV = OFF_BAR + SZ_BAR;
constexpr size_t OFF_TW = OFF_MODV + SZ_MODV;
constexpr size_t OFF_CNT = OFF_TW + SZ_TW;
constexpr size_t OFF_LIST = OFF_CNT + SZ_CNT;
constexpr size_t OFF_TOKINFO = OFF_LIST + SZ_LIST;
constexpr size_t OFF_CRES = OFF_TOKINFO + SZ_TOKINFO;
constexpr size_t OFF_XN = OFF_CRES + SZ_CRES;
constexpr size_t OFF_YS = OFF_XN + SZ_XN;
constexpr size_t OFF_WTIN = OFF_YS + SZ_YS;
constexpr size_t OFF_WTGATE = OFF_WTIN + SZ_WTIN;
constexpr size_t OFF_WTBR = OFF_WTGATE + SZ_WTGATE;
constexpr size_t OFF_WTOUT = OFF_WTBR + SZ_WTBR;
constexpr size_t OFF_WTGLU = OFF_WTOUT + SZ_WTOUT;
constexpr size_t OFF_HYREG = OFF_WTGLU + SZ_WTGLU;
constexpr size_t OFF_UT = OFF_HYREG;
constexpr size_t OFF_HSPEC = OFF_UT + SZ_UT;
constexpr size_t OFF_UTC = OFF_HSPEC + SZ_HSPEC;
constexpr size_t OFF_FC = OFF_UTC + SZ_UTC;
constexpr size_t OFF_H2 = OFF_FC + SZ_FC;
constexpr size_t SZ_HYREG_RAW = SZ_UT + SZ_HSPEC + SZ_UTC + SZ_FC + SZ_H2;
constexpr size_t SZ_HYREG = SZ_HYREG_RAW > SZ_MERGED ? SZ_HYREG_RAW : SZ_MERGED;
constexpr size_t OFF_MERGED = OFF_HYREG;
constexpr size_t OFF_S5E = OFF_HYREG + SZ_HYREG;
constexpr size_t OFF_S5BB = OFF_S5E + SZ_S5E;
constexpr size_t OFF_S5KC = OFF_S5BB + SZ_S5BB;
constexpr size_t OFF_S5PM = OFF_S5KC + SZ_S5KC;
constexpr size_t OFF_S5RM = OFF_S5PM + SZ_S5PM;
constexpr size_t OFF_S5ST = OFF_S5RM + SZ_S5RM;
constexpr size_t OFF_S5XE = OFF_S5ST + SZ_S5ST;
constexpr size_t OFF_S5Y1 = OFF_S5XE + SZ_S5XE;
constexpr size_t OFF_MST = OFF_S5Y1 + SZ_S5Y1;
constexpr size_t OFF_MCD = OFF_MST + SZ_MST;
constexpr size_t OFF_RP = OFF_MCD + SZ_MCD;
constexpr size_t OFF_RQ = OFF_RP + SZ_RP;
constexpr size_t OFF_Y2 = OFF_RP;
static_assert(SZ_Y2 <= SZ_RP + SZ_RQ, "Y2 alias");
constexpr size_t OFF_P = OFF_RQ + SZ_RQ;
constexpr size_t OFF_WTGU = OFF_P;
constexpr size_t OFF_WTDN = OFF_WTGU + SZ_WTGU;
constexpr size_t OFF_HB = OFF_WTDN + SZ_WTDN;
constexpr size_t SZ_PREG_MOE = SZ_WTGU + SZ_WTDN + SZ_HB;
constexpr size_t SZ_PREG = SZ_P > SZ_PREG_MOE ? SZ_P : SZ_PREG_MOE;
constexpr size_t WS_TOTAL = OFF_P + SZ_PREG;
#if CFG_BATCH == 4 && CFG_SEQ == 4096 && CFG_CTX == 256
static_assert(WS_TOTAL <= (size_t)382 * 1024 * 1024, "workspace budget");
#endif

struct Params {
    const float* in[N_IN];
    float* out;
    char* ws;
};

#define WSP(P, T_, off) ((T_*)((P).ws + (off)))

constexpr int SMEM_BYTES = 65536 + 512;

constexpr int LDT = 72;
template <int NT, class AF, class BF>
__device__ __forceinline__ void gemm_acc(f32x4 (&acc)[4][NT], int K, AF af, BF bf, bf16_t* As, bf16_t* Bs) {
    constexpr int BN = 32 * NT;
    constexpr int NBCH = BN * 8 / 256;
    const int tid = threadIdx.x, lane = tid & 63, wv = tid >> 6, wm = wv >> 1, wn = wv & 1;
    uint4 ra[4], rb[NBCH];
    const int nk = K / 64;
    auto gload = [&](int kt) {
#pragma unroll
        for (int q = 0; q < 4; ++q) { int id = tid + 256 * q; int r = id >> 3, kc = id & 7;
            const bf16_t* p = af(r, kt * 8 + kc); ra[q] = p ? *(const uint4*)p : make_uint4(0, 0, 0, 0); }
#pragma unroll
        for (int q = 0; q < NBCH; ++q) { int id = tid + 256 * q; int r = id >> 3, kc = id & 7;
            const bf16_t* p = bf(r, kt * 8 + kc); rb[q] = p ? *(const uint4*)p : make_uint4(0, 0, 0, 0); }
    };
    gload(0);
    __syncthreads();
#pragma unroll 1
    for (int kt = 0; kt < nk; ++kt) {
#pragma unroll
        for (int q = 0; q < 4; ++q) { int id = tid + 256 * q; int r = id >> 3, kc = id & 7; *(uint4*)(As + r * LDT + kc * 8) = ra[q]; }
#pragma unroll
        for (int q = 0; q < NBCH; ++q) { int id = tid + 256 * q; int r = id >> 3, kc = id & 7; *(uint4*)(Bs + r * LDT + kc * 8) = rb[q]; }
        __syncthreads();
        if (kt + 1 < nk) gload(kt + 1);
#pragma unroll
        for (int kk = 0; kk < 2; ++kk) {
            bf16x8 a[4], b[NT];
#pragma unroll
            for (int i = 0; i < 4; ++i) a[i] = *(const bf16x8*)(As + (wm * 64 + i * 16 + (lane & 15)) * LDT + kk * 32 + (lane >> 4) * 8);
#pragma unroll
            for (int j = 0; j < NT; ++j) b[j] = *(const bf16x8*)(Bs + (wn * 16 * NT + j * 16 + (lane & 15)) * LDT + kk * 32 + (lane >> 4) * 8);
#pragma unroll
            for (int i = 0; i < 4; ++i)
#pragma unroll
                for (int j = 0; j < NT; ++j) acc[i][j] = MFMA16(b[j], a[i], acc[i][j]);
        }
        __syncthreads();
    }
}
template <int NT, class EF>
__device__ __forceinline__ void gemm_epi(f32x4 (&acc)[4][NT], EF ef) {
    const int tid = threadIdx.x, lane = tid & 63, wv = tid >> 6, wm = wv >> 1, wn = wv & 1;
#pragma unroll
    for (int i = 0; i < 4; ++i)
#pragma unroll
        for (int j = 0; j < NT; ++j) ef(wm * 64 + i * 16 + (lane & 15), wn * 16 * NT + j * 16 + (lane >> 4) * 4, acc[i][j]);
}
template <int NT>
__device__ __forceinline__ void acc_zero(f32x4 (&acc)[4][NT]) {
#pragma unroll
    for (int i = 0; i < 4; ++i)
#pragma unroll
        for (int j = 0; j < NT; ++j) acc[i][j] = (f32x4){0.f, 0.f, 0.f, 0.f};
}

__device__ __forceinline__ float wave_sum(float v) {
#pragma unroll
    for (int m = 32; m >= 1; m >>= 1) v += __shfl_xor(v, m);
    return v;
}
__device__ __forceinline__ int mod_row(int row) { return row < NX ? row / SEQ : NB; }
__device__ __forceinline__ float* res_ptr(const Params& P, int row) {
    return row < NX ? P.out + (size_t)row * D : WSP(P, float, OFF_CRES) + (size_t)(row - NX) * D;
}

__device__ void convT_tile(const float* src, int lds_, int col0, int nvalid, bf16_t* dst, int ldd, int n0, int k0, char* smem) {
    float* tile = (float*)smem;
    const int tid = threadIdx.x;
    __syncthreads();
#pragma unroll
    for (int q = 0; q < 16; ++q) { int id = tid + 256 * q; int kk = id >> 6, j = id & 63;
        float v = (n0 + j < nvalid) ? src[(size_t)(k0 + kk) * lds_ + col0 + n0 + j] : 0.f;
        tile[kk * 65 + j] = v; }
    __syncthreads();
#pragma unroll
    for (int q = 0; q < 8; ++q) { int id = tid + 256 * q; int j = id >> 5, k2 = (id & 31) * 2;
        unsigned v = pack2(tile[k2 * 65 + j], tile[(k2 + 1) * 65 + j]);
        *(unsigned*)(dst + (size_t)(n0 + j) * ldd + k0 + k2) = v; }
}

constexpr int CV_A = 32 * 16;
constexpr int CV_B = 18 * 16;
constexpr int CV_G = 64 * 16;
constexpr int CV_BR = 4 * 16 * 4;
constexpr int CV_OUT = 16 * 16;
constexpr int CV_GLU = 4 * 4;
constexpr int CV_MAIN = CV_A + CV_B + CV_G + CV_BR + CV_OUT + CV_GLU;
__device__ void conv_main_item(const Params& P, int l, int it, char* smem) {
    const float* w_in = P.in[I_WIN] + (size_t)l * D * IN_COLS;
    if (it < CV_A) { convT_tile(w_in, IN_COLS, 0, 1984, WSP(P, bf16_t, OFF_WTIN), D, (it / 16) * 64, (it % 16) * 64, smem); return; }
    it -= CV_A;
    if (it < CV_B) { convT_tile(w_in, IN_COLS, 1984, 1032, WSP(P, bf16_t, OFF_WTIN) + (size_t)2048 * D, D, (it / 16) * 64, (it % 16) * 64, smem); return; }
    it -= CV_B;
    if (it < CV_G) { convT_tile(w_in, IN_COLS, 3016, 4096, WSP(P, bf16_t, OFF_WTGATE), D, (it / 16) * 64, (it % 16) * 64, smem); return; }
    it -= CV_G;
    if (it < CV_BR) { int br = it / 64, r = it % 64;
        convT_tile(P.in[I_WBR] + ((size_t)l * 4 + br) * 256 * D, D, 0, D, WSP(P, bf16_t, OFF_WTBR) + (size_t)br * D * 256, 256, (r / 4) * 64, (r % 4) * 64, smem); return; }
    it -= CV_BR;
    if (it < CV_OUT) { convT_tile(P.in[I_WOUT] + (size_t)l * D * D, D, 0, D, WSP(P, bf16_t, OFF_WTOUT), D, (it / 16) * 64, (it % 16) * 64, smem); return; }
    it -= CV_OUT;
    convT_tile(P.in[I_SGLU] + (size_t)l * 256 * 256, 256, 0, 256, WSP(P, bf16_t, OFF_WTGLU), 256, (it / 4) * 64, (it % 4) * 64, smem);
}
constexpr int CV_MOE = 16 * (2 * 8 * 16 + 16 * 8);
__device__ void conv_moe_item(const Params& P, int l, int it, char* smem) {
    int e = it / 384, r = it % 384;
    if (r < 256) { int which = r / 128, rr = r % 128;
        const float* src = P.in[which ? I_MOEUP : I_MOEGATE] + ((size_t)l * 16 + e) * D * 512;
        convT_tile(src, 512, 0, 512, WSP(P, bf16_t, OFF_WTGU) + (size_t)e * 1024 * 1024 + (size_t)which * 1024, 2048, (rr / 16) * 64, (rr % 16) * 64, smem);
    } else { int rr = r - 256;
        convT_tile(P.in[I_MOEDOWN] + ((size_t)l * 16 + e) * 512 * D, D, 0, D, WSP(P, bf16_t, OFF_WTDN) + (size_t)e * 1024 * 512, 512, (rr / 8) * 64, (rr % 8) * 64, smem);
    }
}

constexpr int MODV_ITEMS = 2 * (6 * D / 64);
__device__ void modv_item(const Params& P, int it, char* smem) {
    const int l = it / 96, cb = it % 96, tid = threadIdx.x;
    float* sc = (float*)smem;
    float* red = sc + NR * D;
    __syncthreads();
    for (int i = tid; i < NR * D; i += 256) { int r = i / D, k = i % D;
        float v = r < NB ? P.in[I_C][r * D + k] : P.in[I_CCTX][k]; sc[i] = siluf_(v); }
    __syncthreads();
    const int col = cb * 64 + (tid & 63), kg = tid >> 6;
    const float* w = P.in[I_MODW] + (size_t)l * D * 6 * D + col;
    float acc[NR];
#pragma unroll
    for (int r = 0; r < NR; ++r) acc[r] = 0.f;
    for (int k = kg * 256; k < kg * 256 + 256; ++k) { float wv = w[(size_t)k * 6 * D];
#pragma unroll
        for (int r = 0; r < NR; ++r) acc[r] += sc[r * D + k] * wv; }
#pragma unroll
    for (int r = 0; r < NR; ++r) red[(kg * NR + r) * 64 + (tid & 63)] = acc[r];
    __syncthreads();
    for (int i = tid; i < NR * 64; i += 256) { int r = i / 64, c = i % 64;
        float s = red[(0 * NR + r) * 64 + c] + red[(1 * NR + r) * 64 + c] + red[(2 * NR + r) * 64 + c] + red[(3 * NR + r) * 64 + c];
        int cc = cb * 64 + c;
        WSP(P, float, OFF_MODV)[((size_t)l * NR + r) * 6 * D + cc] = s + P.in[I_MODB][(size_t)l * 6 * D + cc]; }
}

constexpr int H2_ITEMS = (SEQ + CTX) / 4;
__device__ void hy_h2_item(const Params& P, int l, int it, char* smem) {
    const int tid = threadIdx.x, j = tid & 63, q = tid >> 6;
    int pos = it * 4 + q;
    int L = pos < SEQ ? SEQ : CTX; int tt = pos < SEQ ? pos : pos - SEQ;
    float* h1 = (float*)smem;
    const float* w1 = P.in[I_HW1] + (size_t)l * 17 * 64; const float* b1 = P.in[I_HB1] + l * 64;
    const float* w2 = P.in[I_HW2] + (size_t)l * 64 * 64; const float* b2 = P.in[I_HB2] + l * 64;
    const float fr = P.in[I_HFREQ][l * 64 + j];
    float tl = (float)tt / (float)(L - 1);
    float wang = 6.283185307179586f * (float)tt / (float)L;
    float a = b1[j] + tl * w1[j];
#pragma unroll
    for (int e = 0; e < 8; ++e) { float f = 1e-4f + (7.0f - 1e-4f) * (float)e / 7.0f; float ang = f * wang;
        a += cosf(ang) * w1[(1 + e) * 64 + j] - sinf(ang) * w1[(9 + e) * 64 + j]; }
    __syncthreads();
    h1[q * 64 + j] = sinf(fr * a);
    __syncthreads();
    float s = b2[j];
    for (int i = 0; i < 64; ++i) s += h1[q * 64 + i] * w2[i * 64 + j];
    WSP(P, float, OFF_H2)[(size_t)pos * 64 + j] = sinf(fr * s);
}

constexpr int TW_ITEMS = (FFTN / 2 + 255) / 256;
__device__ void tw_item(const Params& P, int it) {
    int k = it * 256 + threadIdx.x;
    if (k < FFTN / 2) { double s, c; sincospi(-2.0 * (double)k / (double)FFTN, &s, &c);
        WSP(P, float2, OFF_TW)[k] = make_float2((float)c, (float)s); }
}

constexpr int S5E_ITEMS = (2 * 16 * 65 * 64) / 256;
constexpr int S5BB_ITEMS = (2 * 16 * 64 * 16) / 256;
__device__ void s5_lam(const Params& P, int l, int d, int g, int n, double& zr, double& zi, double& lr, double& li) {
    size_t idx = (((size_t)l * 2 + d) * 16 + g) * 64 + n;
    lr = (double)P.in[I_SLR][idx]; li = (double)P.in[I_SLI][idx];
    double step = exp((double)P.in[I_SSTEP][((size_t)l * 2 + d) * 16 + g]);
    zr = lr * step; zi = li * step;
}
__device__ void s5e_item(const Params& P, int l, int it) {
    int id = it * 256 + threadIdx.x;
    int n = id & 63, tau = (id >> 6) % 65, g = (id / (64 * 65)) % 16, d = id / (64 * 65 * 16);
    double zr, zi, lr, li; s5_lam(P, l, d, g, n, zr, zi, lr, li);
    double mag = exp(zr * tau), s, c; sincos(zi * tau, &s, &c);
    WSP(P, float2, OFF_S5E)[id] = make_float2((float)(mag * c), (float)(mag * s));
}
__device__ void s5bb_item(const Params& P, int l, int it) {
    int id = it * 256 + threadIdx.x;
    int i = id & 15, n = (id >> 4) & 63, g = (id >> 10) & 15, d = id >> 14;
    double zr, zi, lr, li; s5_lam(P, l, d, g, n, zr, zi, lr, li);
    double mag = exp(zr), s, c; sincos(zi, &s, &c);
    double ar = mag * c - 1.0, ai = mag * s;
    double den = lr * lr + li * li;
    double qr = (ar * lr + ai * li) / den, qi = (ai * lr - ar * li) / den;
    size_t bi = ((((size_t)l * 2 + d) * 16 + g) * 64 + n) * 16 + i;
    double br = (double)P.in[I_SBR][bi], bim = (double)P.in[I_SBI][bi];
    WSP(P, float2, OFF_S5BB)[id] = make_float2((float)(qr * br - qi * bim), (float)(qr * bim + qi * br));
}

constexpr int COPY_ITEMS = T * D / 4 / 1024;
__device__ void copy_item(const Params& P, int it) {
#pragma unroll
    for (int q = 0; q < 4; ++q) { size_t i4 = (size_t)it * 1024 + q * 256 + threadIdx.x;
        size_t nx4 = (size_t)NX * D / 4;
        if (i4 < nx4) ((float4*)P.out)[i4] = ((const float4*)P.in[I_X])[i4];
        else WSP(P, float4, OFF_CRES)[i4 - nx4] = ((const float4*)P.in[I_CTX])[i4 - nx4]; }
}

constexpr int NORM_ITEMS = T / 4;
__device__ void norm_item(const Params& P, int l, int which  , bool from_input, int it) {
    const int lane = threadIdx.x & 63, row = it * 4 + (threadIdx.x >> 6);
    const float* src = from_input ? (row < NX ? P.in[I_X] + (size_t)row * D : P.in[I_CTX] + (size_t)(row - NX) * D) : res_ptr(P, row);
    float4 v[4]; float ss = 0.f;
#pragma unroll
    for (int q = 0; q < 4; ++q) { v[q] = ((const float4*)src)[q * 64 + lane]; ss += v[q].x * v[q].x + v[q].y * v[q].y + v[q].z * v[q].z + v[q].w * v[q].w; }
    ss = wave_sum(ss);
    float rstd = rsqrtf(ss * (1.0f / D) + 1e-6f);
    const float* g = P.in[which ? I_NFFN : I_NMIX] + (size_t)l * D;
    const float* mv = WSP(P, float, OFF_MODV) + ((size_t)l * NR + mod_row(row)) * 6 * D;
    const float* sh = mv + (which ? 3 : 0) * D; const float* sc = mv + (which ? 4 : 1) * D;
    bf16_t* dst = WSP(P, bf16_t, OFF_XN) + (size_t)row * D;
#pragma unroll
    for (int q = 0; q < 4; ++q) { int c = (q * 64 + lane) * 4;
        float4 gg = *(const float4*)(g + c), s4 = *(const float4*)(sc + c), h4 = *(const float4*)(sh + c);
        float o0 = v[q].x * rstd * gg.x * (1.f + s4.x) + h4.x, o1 = v[q].y * rstd * gg.y * (1.f + s4.y) + h4.y;
        float o2 = v[q].z * rstd * gg.z * (1.f + s4.z) + h4.z, o3 = v[q].w * rstd * gg.w * (1.f + s4.w) + h4.w;
        *(uint2*)(dst + c) = make_uint2(pack2(o0, o1), pack2(o2, o3)); }
}

constexpr int G1_NT = NP / 128;
constexpr int G1_ITEMS = (T / 128) * G1_NT;
__device__ void g1_item(const Params& P, int l, int it, char* smem) {
    const int MT = T / 128;
    int grp = it / (8 * G1_NT), rem = it % (8 * G1_NT);
    int gm = MT - grp * 8 < 8 ? MT - grp * 8 : 8;
    int mt = grp * 8 + rem % gm, nt = rem / gm;
    if (rem >= gm * G1_NT) return;
    if (l == 1 && mt * 128 >= NX && nt < 6) return;
    const bf16_t* A = WSP(P, bf16_t, OFF_XN) + (size_t)mt * 128 * D;
    const bf16_t* B = WSP(P, bf16_t, OFF_WTIN) + (size_t)nt * 128 * D;
    bf16_t* As = (bf16_t*)smem; bf16_t* Bs = As + 128 * LDT;
    f32x4 acc[4][4]; acc_zero<4>(acc);
    gemm_acc<4>(acc, D, [&](int r, int kc) { return A + (size_t)r * D + kc * 8; }, [&](int r, int kc) { return B + (size_t)r * D + kc * 8; }, As, Bs);
    bf16_t* Pp = WSP(P, bf16_t, OFF_P) + (size_t)mt * 128 * NP + nt * 128;
    gemm_epi<4>(acc, [&](int m, int n, f32x4 v) { *(uint2*)(Pp + (size_t)m * NP + n) = make_uint2(pack2(v[0], v[1]), pack2(v[2], v[3])); });
}


constexpr int S5KC_ITEMS = 16 * 127;
__device__ void s5kc_item(const Params& P, int l, int it) {
    const int g = it / 127, tp = it % 127, tid = threadIdx.x, i = tid >> 4, ip = tid & 15;
    const float2* E = WSP(P, float2, OFF_S5E); const float2* BB = WSP(P, float2, OFF_S5BB);
    float acc = 0.f;
    for (int d = 0; d < 2; ++d) {
        int tau = d == 0 ? tp - 63 : 63 - tp;
        if (tau < 0) continue;
        const float* cre = P.in[I_SCR] + ((((size_t)l * 2 + d) * 16 + g) * 16 + i) * 64;
        const float* cim = P.in[I_SCI] + ((((size_t)l * 2 + d) * 16 + g) * 16 + i) * 64;
        for (int n = 0; n < 64; ++n) {
            float2 e = E[((d * 16 + g) * 65 + tau) * 64 + n]; float2 b = BB[((d * 16 + g) * 64 + n) * 16 + ip];
            float zr = e.x * b.x - e.y * b.y, zi = e.x * b.y + e.y * b.x;
            acc += cre[n] * zr - cim[n] * zi;
        }
    }
    WSP(P, bf16_t, OFF_S5KC)[((size_t)g * 127 + tp) * 256 + tid] = f2bf(acc);
}
constexpr int S5PM_ITEMS = 16 * 2 * 64;
__device__ void s5pm_item(const Params& P, int it) {
    const int n = it & 63, d = (it >> 6) & 1, g = it >> 7, tid = threadIdx.x;
    const float2* E = WSP(P, float2, OFF_S5E); const float2* BB = WSP(P, float2, OFF_S5BB);
    bf16_t* pr = WSP(P, bf16_t, OFF_S5PM) + ((size_t)g * 256 + d * 128 + n) * 1024;
    bf16_t* pi = pr + (size_t)64 * 1024;
#pragma unroll
    for (int q = 0; q < 4; ++q) { int k = tid + 256 * q; int s = k >> 4, i = k & 15;
        int tau = d == 0 ? 63 - s : s;
        float2 e = E[((d * 16 + g) * 65 + tau) * 64 + n]; float2 b = BB[((d * 16 + g) * 64 + n) * 16 + i];
        pr[k] = f2bf(e.x * b.x - e.y * b.y); pi[k] = f2bf(e.x * b.y + e.y * b.x); }
}
constexpr int S5RM_ITEMS = 16 * 64;
__device__ void s5rm_item(const Params& P, int l, int it) {
    const int t = it & 63, g = it >> 6, tid = threadIdx.x;
    const float2* E = WSP(P, float2, OFF_S5E);
#pragma unroll
    for (int q = 0; q < 16; ++q) { int id = tid + 256 * q; int col = id & 255, i = id >> 8;
        int d = col >> 7, part = (col >> 6) & 1, n = col & 63;
        int tau = d == 0 ? t + 1 : 64 - t;
        size_t ci = ((((size_t)l * 2 + d) * 16 + g) * 16 + i) * 64 + n;
        float cr = P.in[I_SCR][ci], cim = P.in[I_SCI][ci];
        float2 e = E[((d * 16 + g) * 65 + tau) * 64 + n];
        float zr = cr * e.x - cim * e.y, zi = cr * e.y + cim * e.x;
        WSP(P, bf16_t, OFF_S5RM)[((size_t)g * 1024 + t * 16 + i) * 256 + col] = f2bf(part == 0 ? zr : -zi); }
}

__device__ __forceinline__ float2 cmul(float2 a, float2 b) { return make_float2(a.x * b.x - a.y * b.y, a.x * b.y + a.y * b.x); }
__device__ void fft_fwd(float2* X, const float2* tw) {
    const int tid = threadIdx.x;
    for (int m = FFTN / 2; m >= 1; m >>= 1) {
        __syncthreads();
        const int tstep = (FFTN / 2) / m;
        for (int j = tid; j < FFTN / 2; j += NTHREADS) {
            int pos = j & (m - 1), i0 = ((j - pos) << 1) + pos, i1 = i0 + m;
            float2 a = X[i0], b = X[i1], w = tw[pos * tstep];
            X[i0] = make_float2(a.x + b.x, a.y + b.y);
            X[i1] = cmul(make_float2(a.x - b.x, a.y - b.y), w);
        }
    }
    __syncthreads();
}
__device__ void fft_inv(float2* X, const float2* tw) {
    const int tid = threadIdx.x;
    for (int m = 1; m <= FFTN / 2; m <<= 1) {
        __syncthreads();
        const int tstep = (FFTN / 2) / m;
        for (int j = tid; j < FFTN / 2; j += NTHREADS) {
            int pos = j & (m - 1), i0 = ((j - pos) << 1) + pos, i1 = i0 + m;
            float2 w = tw[pos * tstep]; w.y = -w.y;
            float2 a = X[i0], b = cmul(X[i1], w);
            X[i0] = make_float2(a.x + b.x, a.y + b.y);
            X[i1] = make_float2(a.x - b.x, a.y - b.y);
        }
    }
    __syncthreads();
}
__device__ __forceinline__ float hy_delta(int c) {
    const float a = -3.0701134573253945f, b = -15.350567286626973f;
    return fabsf(a + (b - a) * (float)c / 255.0f);
}
constexpr int HSPEC_ITEMS = 256;
__device__ void hspec_item(const Params& P, int l, int c, char* smem) {
    float2* X = (float2*)smem;
    float* w3s = (float*)(smem + 65536);
    const int tid = threadIdx.x;
    const float* w3 = P.in[I_HW3] + (size_t)l * 64 * 512;
    const float* h2 = WSP(P, float, OFF_H2);
    __syncthreads();
    if (tid < 128) w3s[tid] = w3[(tid & 63) * 512 + (tid >> 6) * 256 + c];
    __syncthreads();
    const float dl = hy_delta(c);
    for (int k = tid; k < FFTN; k += NTHREADS) {
        float v = 0.f;
        if (k != SEQ) { int tau = k < SEQ ? k : FFTN - k; const float* w = k < SEQ ? w3s : w3s + 64;
            const float* hr = h2 + (size_t)tau * 64; float s = 0.f;
            for (int j = 0; j < 64; ++j) s += hr[j] * w[j];
            v = s * __expf(-dl * (float)tau / (float)(SEQ - 1)); }
        X[k] = make_float2(v, 0.f);
    }
    fft_fwd(X, WSP(P, float2, OFF_TW));
    float2* dst = WSP(P, float2, OFF_HSPEC) + (size_t)c * FFTN;
    for (int k = tid; k < FFTN; k += NTHREADS) dst[k] = X[k];
    if (l == 0) {
        for (int k = tid; k < 2 * CTX; k += NTHREADS) { int dir = k / CTX, tau = k % CTX;
            const float* hr = h2 + (size_t)(SEQ + tau) * 64; const float* w = w3s + dir * 64; float s = 0.f;
            for (int j = 0; j < 64; ++j) s += hr[j] * w[j];
            WSP(P, float, OFF_FC)[((size_t)dir * 256 + c) * CTX + tau] = s * __expf(-dl * (float)tau / (float)(CTX - 1)); }
    }
}


__device__ __forceinline__ float geluf_(float x) { float u = 0.7978845608028654f * (x + 0.044715f * x * x * x); return 0.5f * x * (1.0f + tanhf(u)); }
constexpr int S5_MT = NCHP / 128;
constexpr int S5A_ITEMS = 16 * S5_MT * 2;
__device__ void s5a_item(const Params& P, int it, char* smem) {
    const int nt = it & 1, mt = (it >> 1) % S5_MT, g = it / (2 * S5_MT);
    const bf16_t* p = WSP(P, bf16_t, OFF_P); const bf16_t* PM = WSP(P, bf16_t, OFF_S5PM);
    bf16_t* As = (bf16_t*)smem; bf16_t* Bs = As + 128 * LDT;
    f32x4 acc[4][4]; acc_zero<4>(acc);
    gemm_acc<4>(acc, 1024,
        [&](int r, int kc) -> const bf16_t* { int ch = mt * 128 + r; if (ch >= NCH) return nullptr; int k = kc * 8;
            return p + (size_t)(ch * 64 + (k >> 4)) * NP + PC_S5 + g * 16 + (k & 15); },
        [&](int r, int kc) -> const bf16_t* { return PM + ((size_t)g * 256 + nt * 128 + r) * 1024 + kc * 8; }, As, Bs);
    float* S = WSP(P, float, OFF_S5ST);
    gemm_epi<4>(acc, [&](int m, int n, f32x4 v) { *(float4*)(S + ((size_t)g * NCHP + mt * 128 + m) * 256 + nt * 128 + n) = make_float4(v[0], v[1], v[2], v[3]); });
}
constexpr int S5B_ITEMS = NB * 16 * 2 * 64 / 256;
__device__ void s5b_item(const Params& P, int it) {
    const int id = it * 256 + threadIdx.x;
    const int n = id & 63, d = (id >> 6) & 1, g = (id >> 7) & 15, b = id >> 11;
    const float2 lam = WSP(P, float2, OFF_S5E)[((d * 16 + g) * 65 + 64) * 64 + n];
    const float* S = WSP(P, float, OFF_S5ST); bf16_t* XE = WSP(P, bf16_t, OFF_S5XE);
    float xr = 0.f, xi = 0.f;
    for (int j = 0; j < CPB; ++j) {
        int ch;
        if (d == 0) ch = j < CC ? NX / 64 + b * CC + j : b * LC + (j - CC);
        else ch = j < CC ? NX / 64 + b * CC + (CC - 1 - j) : b * LC + (LC - 1 - (j - CC));
        size_t o = ((size_t)g * NCHP + ch) * 256 + d * 128 + n;
        XE[o] = f2bf(xr); XE[o + 64] = f2bf(xi);
        float sr = S[o], si = S[o + 64];
        float nr = lam.x * xr - lam.y * xi + sr, ni = lam.x * xi + lam.y * xr + si;
        xr = nr; xi = ni;
    }
}
constexpr int S5C_ITEMS = 16 * S5_MT * 8;
__device__ void s5c_item(const Params& P, int l, int it, char* smem) {
    const int nt = it & 7, mt = (it >> 3) % S5_MT, g = it / (8 * S5_MT);
    const bf16_t* p = WSP(P, bf16_t, OFF_P); const bf16_t* KC = WSP(P, bf16_t, OFF_S5KC);
    const bf16_t* RM = WSP(P, bf16_t, OFF_S5RM); const bf16_t* XE = WSP(P, bf16_t, OFF_S5XE);
    bf16_t* As = (bf16_t*)smem; bf16_t* Bs = As + 128 * LDT;
    f32x4 acc[4][4]; acc_zero<4>(acc);
    gemm_acc<4>(acc, 1280,
        [&](int r, int kc) -> const bf16_t* { int ch = mt * 128 + r; if (ch >= NCH) return nullptr;
            if (kc < 128) { int k = kc * 8; return p + (size_t)(ch * 64 + (k >> 4)) * NP + PC_S5 + g * 16 + (k & 15); }
            return XE + ((size_t)g * NCHP + ch) * 256 + (kc - 128) * 8; },
        [&](int r, int kc) -> const bf16_t* { int n = nt * 128 + r, t = n >> 4, i = n & 15;
            if (kc < 128) { int k = kc * 8, s = k >> 4; return KC + (((size_t)g * 127 + (t - s + 63)) * 16 + i) * 16 + (k & 15); }
            return RM + ((size_t)g * 1024 + n) * 256 + (kc - 128) * 8; }, As, Bs);
    const float* dsk = P.in[I_SD] + (size_t)l * 256; bf16_t* Y1 = WSP(P, bf16_t, OFF_S5Y1);
    gemm_epi<4>(acc, [&](int m, int n, f32x4 v) { int ch = mt * 128 + m; if (ch >= NCH) return;
        int nn = nt * 128 + n, t = nn >> 4, i = nn & 15; size_t row = (size_t)ch * 64 + t; int col = g * 16 + i;
        uint2 uu = *(const uint2*)(p + row * NP + PC_S5 + col);
        float u0 = u2f(uu.x << 16), u1 = u2f(uu.x & 0xffff0000u), u2 = u2f(uu.y << 16), u3 = u2f(uu.y & 0xffff0000u);
        float y0 = geluf_(v[0] + dsk[col] * u0), y1 = geluf_(v[1] + dsk[col + 1] * u1), y2 = geluf_(v[2] + dsk[col + 2] * u2), y3 = geluf_(v[3] + dsk[col + 3] * u3);
        *(uint2*)(Y1 + row * 256 + col) = make_uint2(pack2(y0, y1), pack2(y2, y3)); });
}
constexpr int S5D_ITEMS = (T / 128) * 2;
__device__ void s5d_item(const Params& P, int it, char* smem) {
    const int nt = it & 1, mt = it >> 1;
    const bf16_t* Y1 = WSP(P, bf16_t, OFF_S5Y1) + (size_t)mt * 128 * 256; const bf16_t* W = WSP(P, bf16_t, OFF_WTGLU) + (size_t)nt * 128 * 256;
    bf16_t* As = (bf16_t*)smem; bf16_t* Bs = As + 128 * LDT;
    f32x4 acc[4][4]; acc_zero<4>(acc);
    gemm_acc<4>(acc, 256, [&](int r, int kc) { return Y1 + (size_t)r * 256 + kc * 8; }, [&](int r, int kc) { return W + (size_t)r * 256 + kc * 8; }, As, Bs);
    bf16_t* out = WSP(P, bf16_t, OFF_YS) + (size_t)1 * T * 256 + (size_t)mt * 128 * 256;
    gemm_epi<4>(acc, [&](int m, int n, f32x4 v) { int col = nt * 128 + n;
        uint2 yy = *(const uint2*)(Y1 + (size_t)m * 256 + col);
        float a0 = u2f(yy.x << 16), a1 = u2f(yy.x & 0xffff0000u), a2 = u2f(yy.y << 16), a3 = u2f(yy.y & 0xffff0000u);
        *(uint2*)(out + (size_t)m * 256 + col) = make_uint2(pack2(a0 * sigmoidf_(v[0]), a1 * sigmoidf_(v[1])), pack2(a2 * sigmoidf_(v[2]), a3 * sigmoidf_(v[3]))); });
}


__device__ __forceinline__ void chunk_seq(int ch, int& s0, int& Ls) {
    if (ch < NX / 64) { s0 = (ch / LC) * SEQ; Ls = SEQ; } else { s0 = NX + ((ch - NX / 64) / CC) * CTX; Ls = CTX; }
}
__device__ __forceinline__ int chunk_order(int b, int d, int j) {
    if (d == 0) return j < CC ? NX / 64 + b * CC + j : b * LC + (j - CC);
    return j < CC ? NX / 64 + b * CC + (CC - 1 - j) : b * LC + (LC - 1 - (j - CC));
}
template <int WC, class F>
__device__ __forceinline__ void m2_conv_cols(const Params& P, int l, int ch, int col0, F f) {
    constexpr int NG = 256 / WC, TP = 64 / NG;
    const int tid = threadIdx.x, c = tid % WC, jg = tid / WC;
    int s0, Ls; chunk_seq(ch, s0, Ls);
    const int col = col0 + c, ci = col - PC_M2_X;
    const float* cw = P.in[I_MCW] + (size_t)l * 3 * 768; const float cb = P.in[I_MCB][(size_t)l * 768 + ci];
    const float w0 = cw[ci], w1 = cw[768 + ci], w2 = cw[1536 + ci];
    const bf16_t* p = WSP(P, bf16_t, OFF_P) + col;
    const int r0 = ch * 64 + jg * TP;
    float pm = (r0 - 1 >= s0) ? bf2f(p[(size_t)(r0 - 1) * NP]) : 0.f;
    float pc = bf2f(p[(size_t)r0 * NP]);
#pragma unroll 4
    for (int jj = 0; jj < TP; ++jj) { int r = r0 + jj;
        float pn = (r + 1 < s0 + Ls) ? bf2f(p[(size_t)(r + 1) * NP]) : 0.f;
        f(jg * TP + jj, c, siluf_(cb + w0 * pm + w1 * pc + w2 * pn));
        pm = pc; pc = pn; }
}
__device__ __forceinline__ void m2_dt_scan(const Params& P, int l, int ch, int h, float* dts, float* acs) {
    const int lane = threadIdx.x & 63;
    const bf16_t* p = WSP(P, bf16_t, OFF_P) + (size_t)(ch * 64 + lane) * NP + PC_M2_DT;
#pragma unroll
    for (int d = 0; d < 2; ++d) {
        float dt = softplusf_(bf2f(p[d * 4 + h]) + P.in[I_MDTB][(size_t)l * 8 + d * 4 + h]);
        float a = -__expf(P.in[I_MALOG][(size_t)l * 8 + d * 4 + h]);
        float lv = dt * a, s = lv;
#pragma unroll
        for (int o = 1; o < 64; o <<= 1) { float t = __shfl_up(s, o); if (lane >= o) s += t; }
        float tot = __shfl(s, 63);
        dts[d * 64 + lane] = dt;
        acs[d * 64 + lane] = d == 0 ? s : tot - s + lv;
    }
}
constexpr int M2A_ITEMS = NCH * 4;
__device__ void m2a_item(const Params& P, int l, int it, char* smem) {
    const int ch = it >> 2, h = it & 3, g = h >> 1, tid = threadIdx.x, lane = tid & 63, wv = tid >> 6;
    bf16_t* XwT = (bf16_t*)smem;
    bf16_t* BT = XwT + 2 * 64 * LDT;
    float* dts = (float*)(BT + 128 * LDT);
    float* acs = dts + 128;
    __syncthreads();
    if (wv == 0) m2_dt_scan(P, l, ch, h, dts, acs);
    __syncthreads();
    m2_conv_cols<64>(P, l, ch, PC_M2_X + h * 64, [&](int j, int c, float v) {
        XwT[c * LDT + j] = f2bf(v * dts[j] * __expf(acs[63] - acs[j]));
        XwT[(64 + c) * LDT + j] = f2bf(v * dts[64 + j] * __expf(acs[64] - acs[64 + j])); });
    m2_conv_cols<128>(P, l, ch, PC_M2_B + g * 128, [&](int j, int c, float v) { BT[c * LDT + j] = f2bf(v); });
    __syncthreads();
    if (tid == 0) { float* cd = WSP(P, float, OFF_MCD) + ((size_t)ch * 4 + h) * 2; cd[0] = __expf(acs[63]); cd[1] = __expf(acs[64]); }
    f32x4 acc[2][4][2];
#pragma unroll
    for (int d = 0; d < 2; ++d)
#pragma unroll
        for (int i = 0; i < 4; ++i)
#pragma unroll
            for (int j = 0; j < 2; ++j) acc[d][i][j] = (f32x4){0.f, 0.f, 0.f, 0.f};
#pragma unroll
    for (int kk = 0; kk < 2; ++kk) {
        bf16x8 b[2];
#pragma unroll
        for (int j = 0; j < 2; ++j) b[j] = *(const bf16x8*)(BT + (wv * 32 + j * 16 + (lane & 15)) * LDT + kk * 32 + (lane >> 4) * 8);
#pragma unroll
        for (int d = 0; d < 2; ++d)
#pragma unroll
            for (int i = 0; i < 4; ++i) { bf16x8 a = *(const bf16x8*)(XwT + (d * 64 + i * 16 + (lane & 15)) * LDT + kk * 32 + (lane >> 4) * 8);
#pragma unroll
                for (int j = 0; j < 2; ++j) acc[d][i][j] = MFMA16(b[j], a, acc[d][i][j]); }
    }
    bf16_t* st = WSP(P, bf16_t, OFF_MST) + ((size_t)ch * 4 + h) * 2 * 8192;
#pragma unroll
    for (int d = 0; d < 2; ++d)
#pragma unroll
        for (int i = 0; i < 4; ++i)
#pragma unroll
            for (int j = 0; j < 2; ++j) { int pp = i * 16 + (lane & 15), n = wv * 32 + j * 16 + (lane >> 4) * 4; f32x4 v = acc[d][i][j];
                *(uint2*)(st + (size_t)d * 8192 + pp * 128 + n) = make_uint2(pack2(v[0], v[1]), pack2(v[2], v[3])); }
}
constexpr int M2B_ITEMS = NB * 4 * 2 * 4096 / 256;
__device__ void m2b_item(const Params& P, int it) {
    const int id = it * 256 + threadIdx.x;
    const int e2 = id & 4095, d = (id >> 12) & 1, h = (id >> 13) & 3, b = id >> 15;
    unsigned* st = WSP(P, unsigned, OFF_MST); const float* cd = WSP(P, float, OFF_MCD);
    float r0 = 0.f, r1 = 0.f;
    for (int j = 0; j < CPB; ++j) { int ch = chunk_order(b, d, j);
        size_t idx = (((size_t)ch * 4 + h) * 2 + d) * 4096 + e2;
        unsigned sv = st[idx]; st[idx] = pack2(r0, r1);
        float dec = cd[((size_t)ch * 4 + h) * 2 + d];
        r0 = r0 * dec + u2f(sv << 16); r1 = r1 * dec + u2f(sv & 0xffff0000u); }
}
constexpr int M2C_ITEMS = NCH;
constexpr int LDW = 136;
__device__ void m2c_item(const Params& P, int l, int ch, char* smem) {
    const int tid = threadIdx.x, lane = tid & 63, wv = tid >> 6;
    bf16_t* Cs = (bf16_t*)smem;
    bf16_t* Bsm = Cs + 64 * LDW;
    bf16_t* Ws = Bsm + 64 * LDW;
    bf16_t* XTs = Ws + 64 * LDT;
    float* dts = (float*)(XTs + 64 * LDT);
    float* acs = dts + 512;
    float* ssq = acs + 512;
    __syncthreads();
    m2_dt_scan(P, l, ch, wv, dts + wv * 128, acs + wv * 128);
    if (tid < 64) ssq[tid] = 0.f;
    bf16_t* out = WSP(P, bf16_t, OFF_YS) + (size_t)3 * T * 256;
#pragma unroll 1
    for (int g = 0; g < 2; ++g) {
        __syncthreads();
        m2_conv_cols<128>(P, l, ch, PC_M2_C + g * 128, [&](int j, int c, float v) { Cs[j * LDW + c] = f2bf(v); });
        m2_conv_cols<128>(P, l, ch, PC_M2_B + g * 128, [&](int j, int c, float v) { Bsm[j * LDW + c] = f2bf(v); });
        __syncthreads();
        f32x4 G[4];
#pragma unroll
        for (int i = 0; i < 4; ++i) G[i] = (f32x4){0.f, 0.f, 0.f, 0.f};
#pragma unroll
        for (int kk = 0; kk < 4; ++kk) { bf16x8 b = *(const bf16x8*)(Bsm + (wv * 16 + (lane & 15)) * LDW + kk * 32 + (lane >> 4) * 8);
#pragma unroll
            for (int i = 0; i < 4; ++i) { bf16x8 a = *(const bf16x8*)(Cs + (i * 16 + (lane & 15)) * LDW + kk * 32 + (lane >> 4) * 8); G[i] = MFMA16(b, a, G[i]); } }
#pragma unroll 1
        for (int hh = 0; hh < 2; ++hh) {
            const int h = g * 2 + hh;
            const float* dtf = dts + h * 128; const float* dtb = dtf + 64; const float* af = acs + h * 128; const float* ab = af + 64;
            __syncthreads();
#pragma unroll
            for (int i = 0; i < 4; ++i) { int ii = i * 16 + (lane & 15), j0 = wv * 16 + (lane >> 4) * 4; float w[4];
#pragma unroll
                for (int e = 0; e < 4; ++e) { int j = j0 + e; float m = 0.f;
                    if (j <= ii) m += __expf(af[ii] - af[j]) * dtf[j];
                    if (j >= ii) m += __expf(ab[ii] - ab[j]) * dtb[j];
                    w[e] = G[i][e] * m; }
                *(uint2*)(Ws + ii * LDT + j0) = make_uint2(pack2(w[0], w[1]), pack2(w[2], w[3])); }
            m2_conv_cols<64>(P, l, ch, PC_M2_X + h * 64, [&](int j, int c, float v) { XTs[c * LDT + j] = f2bf(v); });
            __syncthreads();
            f32x4 ay[4];
#pragma unroll
            for (int i = 0; i < 4; ++i) ay[i] = (f32x4){0.f, 0.f, 0.f, 0.f};
#pragma unroll
            for (int kk = 0; kk < 2; ++kk) { bf16x8 b = *(const bf16x8*)(XTs + (wv * 16 + (lane & 15)) * LDT + kk * 32 + (lane >> 4) * 8);
#pragma unroll
                for (int i = 0; i < 4; ++i) { bf16x8 a = *(const bf16x8*)(Ws + (i * 16 + (lane & 15)) * LDT + kk * 32 + (lane >> 4) * 8); ay[i] = MFMA16(b, a, ay[i]); } }
#pragma unroll
            for (int d = 0; d < 2; ++d) {
                __syncthreads();
                const bf16_t* hs = WSP(P, bf16_t, OFF_MST) + (((size_t)ch * 4 + h) * 2 + d) * 8192;
#pragma unroll
                for (int q = 0; q < 4; ++q) { int id = tid + 256 * q; int r = id >> 4, c8 = id & 15; *(uint4*)(Bsm + r * LDW + c8 * 8) = *(const uint4*)(hs + r * 128 + c8 * 8); }
                __syncthreads();
                f32x4 ao[4];
#pragma unroll
                for (int i = 0; i < 4; ++i) ao[i] = (f32x4){0.f, 0.f, 0.f, 0.f};
#pragma unroll
                for (int kk = 0; kk < 4; ++kk) { bf16x8 b = *(const bf16x8*)(Bsm + (wv * 16 + (lane & 15)) * LDW + kk * 32 + (lane >> 4) * 8);
#pragma unroll
                    for (int i = 0; i < 4; ++i) { bf16x8 a = *(const bf16x8*)(Cs + (i * 16 + (lane & 15)) * LDW + kk * 32 + (lane >> 4) * 8); ao[i] = MFMA16(b, a, ao[i]); } }
                const float* aa = d == 0 ? af : ab;
#pragma unroll
                for (int i = 0; i < 4; ++i) { float sc = __expf(aa[i * 16 + (lane & 15)]);
#pragma unroll
                    for (int e = 0; e < 4; ++e) ay[i][e] += sc * ao[i][e]; }
            }
            const float dskip = P.in[I_MD][(size_t)l * 4 + h];
#pragma unroll
            for (int i = 0; i < 4; ++i) { int ii = i * 16 + (lane & 15), p0 = wv * 16 + (lane >> 4) * 4;
                uint2 zz = *(const uint2*)(WSP(P, bf16_t, OFF_P) + (size_t)(ch * 64 + ii) * NP + PC_M2_Z + h * 64 + p0);
                float z[4] = {u2f(zz.x << 16), u2f(zz.x & 0xffff0000u), u2f(zz.y << 16), u2f(zz.y & 0xffff0000u)};
                float sq = 0.f, yy[4];
#pragma unroll
                for (int e = 0; e < 4; ++e) { float y = ay[i][e] + dskip * bf2f(XTs[(p0 + e) * LDT + ii]); y *= siluf_(z[e]); yy[e] = y; sq += y * y; }
                *(uint2*)(out + (size_t)(ch * 64 + ii) * 256 + h * 64 + p0) = make_uint2(pack2(yy[0], yy[1]), pack2(yy[2], yy[3]));
                sq += __shfl_xor(sq, 16); sq += __shfl_xor(sq, 32);
                if (lane < 16) atomicAdd(&ssq[ii], sq); }
        }
    }
    __syncthreads();
    const float* nw = P.in[I_MNW] + (size_t)l * 256;
#pragma unroll 1
    for (int h = 0; h < 4; ++h)
#pragma unroll
        for (int i = 0; i < 4; ++i) { int ii = i * 16 + (lane & 15), c0 = h * 64 + wv * 16 + (lane >> 4) * 4;
            float rs = rsqrtf(ssq[ii] * (1.0f / 256.0f) + 1e-6f);
            uint2* op = (uint2*)(out + (size_t)(ch * 64 + ii) * 256 + c0); uint2 yy = *op;
            *op = make_uint2(pack2(u2f(yy.x << 16) * rs * nw[c0], u2f(yy.x & 0xffff0000u) * rs * nw[c0 + 1]),
                             pack2(u2f(yy.y << 16) * rs * nw[c0 + 2], u2f(yy.y & 0xffff0000u) * rs * nw[c0 + 3])); }
}


template <class F>
__device__ __forceinline__ void hy_conv_cols(const Params& P, int l, int ch, int col0, F f) {
    const int tid = threadIdx.x, c = tid & 127, jg = tid >> 7;
    int s0, Ls; chunk_seq(ch, s0, Ls);
    const int col = col0 + c;
    const float* cw = P.in[I_HCW] + (size_t)l * 3 * 768; const float cb = P.in[I_HCB][(size_t)l * 768 + col];
    const float w0 = cw[col], w1 = cw[768 + col], w2 = cw[1536 + col];
    const bf16_t* p = WSP(P, bf16_t, OFF_P) + col;
    const int r0 = ch * 64 + jg * 32;
    float pm = (r0 - 1 >= s0) ? bf2f(p[(size_t)(r0 - 1) * NP]) : 0.f;
    float pc = bf2f(p[(size_t)r0 * NP]);
#pragma unroll 4
    for (int jj = 0; jj < 32; ++jj) { int r = r0 + jj;
        float pn = (r + 1 < s0 + Ls) ? bf2f(p[(size_t)(r + 1) * NP]) : 0.f;
        f(jg * 32 + jj, c, cb + w0 * pm + w1 * pc + w2 * pn);
        pm = pc; pc = pn; }
}
__device__ __forceinline__ float* hy_ut_ptr(const Params& P, int ch, int c) {
    if (ch < NX / 64) { int b = ch / LC; return WSP(P, float, OFF_UT) + ((size_t)b * 256 + c) * SEQ + (size_t)(ch % LC) * 64; }
    int cb = ch - NX / 64, b = cb / CC; return WSP(P, float, OFF_UTC) + ((size_t)b * 256 + c) * CTX + (size_t)(cb % CC) * 64;
}
constexpr int HY1_ITEMS = NCH * 2;
__device__ void hy1_item(const Params& P, int l, int it, char* smem) {
    const int ch = it >> 1, hf = it & 1, tid = threadIdx.x;
    if (l == 1 && ch >= NX / 64) return;
    float* tile = (float*)smem;
    __syncthreads();
    hy_conv_cols(P, l, ch, 256 + hf * 128, [&](int j, int c, float v) { tile[c * 65 + j] = v; });
    hy_conv_cols(P, l, ch, 512 + hf * 128, [&](int j, int c, float v) { tile[c * 65 + j] *= v; });
    __syncthreads();
    const int j = tid & 63, cq = tid >> 6;
#pragma unroll 4
    for (int i = 0; i < 32; ++i) { int c = cq + 4 * i; hy_ut_ptr(P, ch, hf * 128 + c)[j] = tile[c * 65 + j]; }
}
static_assert(CTX <= 256, "ctx direct conv uses one thread per position");
constexpr int HY2_ITEMS = 256;
__device__ void hy2_item(const Params& P, int l, int c, char* smem) {
    float2* X = (float2*)smem; const int tid = threadIdx.x;
    const float2* tw = WSP(P, float2, OFF_TW); const float2* H = WSP(P, float2, OFF_HSPEC) + (size_t)c * FFTN;
    const float bias = P.in[I_HBIAS][(size_t)l * 256 + c];
    for (int pr = 0; pr < NB / 2; ++pr) {
        float* u0 = WSP(P, float, OFF_UT) + ((size_t)(2 * pr) * 256 + c) * SEQ; float* u1 = u0 + (size_t)256 * SEQ;
        __syncthreads();
        for (int t = tid; t < FFTN; t += NTHREADS) X[t] = t < SEQ ? make_float2(u0[t], u1[t]) : make_float2(0.f, 0.f);
        fft_fwd(X, tw);
        for (int k = tid; k < FFTN; k += NTHREADS) X[k] = cmul(X[k], H[k]);
        fft_inv(X, tw);
        const float sc = 1.0f / (float)FFTN;
        for (int t = tid; t < SEQ; t += NTHREADS) { float a = u0[t], b = u1[t]; u0[t] = X[t].x * sc + bias * a; u1[t] = X[t].y * sc + bias * b; }
    }
    if (l == 0) {
        float* us = (float*)smem;
        float* fs = us + NB * CTX;
        __syncthreads();
        for (int i = tid; i < NB * CTX; i += NTHREADS) us[i] = WSP(P, float, OFF_UTC)[((size_t)(i / CTX) * 256 + c) * CTX + (i % CTX)];
        for (int i = tid; i < 2 * CTX; i += NTHREADS) fs[i] = WSP(P, float, OFF_FC)[((size_t)(i / CTX) * 256 + c) * CTX + (i % CTX)];
        __syncthreads();
        if (tid < CTX) { const int t = tid;
            for (int b = 0; b < NB; ++b) { float y = 0.f;
                for (int s2 = 0; s2 <= t; ++s2) y += us[b * CTX + s2] * fs[t - s2];
                for (int s2 = t + 1; s2 < CTX; ++s2) y += us[b * CTX + s2] * fs[CTX + s2 - t];
                WSP(P, float, OFF_UTC)[((size_t)b * 256 + c) * CTX + t] = y + bias * us[b * CTX + t]; } }
    }
}
constexpr int HY3_ITEMS = NCH * 2;
__device__ void hy3_item(const Params& P, int l, int it, char* smem) {
    const int ch = it >> 1, hf = it & 1, tid = threadIdx.x;
    if (l == 1 && ch >= NX / 64) return;
    float* tile = (float*)smem;
    __syncthreads();
    { const int j = tid & 63, cq = tid >> 6;
#pragma unroll 4
      for (int i = 0; i < 32; ++i) { int c = cq + 4 * i; tile[c * 65 + j] = hy_ut_ptr(P, ch, hf * 128 + c)[j]; } }
    __syncthreads();
    bf16_t* out = WSP(P, bf16_t, OFF_YS);
    hy_conv_cols(P, l, ch, hf * 128, [&](int j, int c, float v) { out[(size_t)(ch * 64 + j) * 256 + hf * 128 + c] = f2bf(v * tile[c * 65 + j]); });
}


__device__ __forceinline__ float rw_mixed(const bf16_t* p, const float* mu, int row, int col, int s0, int Ls) {
    const bf16_t* q = p + (size_t)row * NP + col;
    float pc = bf2f(q[0]);
    float pm = row - 1 >= s0 ? bf2f(q[-NP]) : 0.f, pn = row + 1 < s0 + Ls ? bf2f(q[NP]) : 0.f;
    return pc + (0.5f * (pm + pn) - pc) * mu[col - PC_RW];
}
constexpr int RL_DEC = 0, RL_KK = 1024, RL_KKA = 2048, RL_KD = 3072, RL_R = 4096, RL_V = 5120, RL_WA = 6144, RL_W2 = 7168, RL_A2 = 9216, RL_Y = 11264, RL_END = 15360;
static_assert(RL_END * 4 <= SMEM_BYTES, "rwkv lds");
__device__ __forceinline__ void rw_load_w(const Params& P, int l, int d, int h, float* L) {
    const int tid = threadIdx.x;
    const float* w2 = P.in[I_RW2] + ((size_t)l * 2 + d) * 32 * 256 + h * 64; const float* a2 = P.in[I_RA2] + ((size_t)l * 2 + d) * 32 * 256 + h * 64;
#pragma unroll
    for (int q = 0; q < 8; ++q) { int id = tid + 256 * q; int j = id >> 6, c = id & 63; L[RL_W2 + id] = w2[j * 256 + c]; L[RL_A2 + id] = a2[j * 256 + c]; }
}
__device__ void rw_prep(const Params& P, int l, int ch, int h, int d, int ss, float* L) {
    const int tid = threadIdx.x, c = tid & 63, tq = tid >> 6, hc = h * 64 + c;
    int s0, Ls; chunk_seq(ch, s0, Ls);
    const bf16_t* p = WSP(P, bf16_t, OFF_P); const float* mu = P.in[I_RMU] + (size_t)l * 960;
    const int rbase = ch * 64 + ss * 16;
    __syncthreads();
#pragma unroll
    for (int q = 0; q < 4; ++q) { int id = tid + 256 * q; int tok = id >> 6, jj = id & 63;
        int col = jj < 32 ? PC_RW_WD + d * 32 + jj : PC_RW_AD + d * 32 + (jj - 32);
        float v = rw_mixed(p, mu, rbase + tok, col, s0, Ls);
        L[RL_WA + id] = jj < 32 ? tanhf(v) : v; }
    __syncthreads();
    const float w0 = P.in[I_RW0][((size_t)l * 2 + d) * 256 + hc], a0 = P.in[I_RA0][((size_t)l * 2 + d) * 256 + hc];
    const float k_k = P.in[I_RKK][(size_t)l * 256 + hc], k_a = P.in[I_RKA][(size_t)l * 256 + hc];
#pragma unroll
    for (int tk = 0; tk < 4; ++tk) { int tok = tq * 4 + tk, row = rbase + tok;
        float r = rw_mixed(p, mu, row, PC_RW_R + hc, s0, Ls), k = rw_mixed(p, mu, row, PC_RW_K + hc, s0, Ls), v = rw_mixed(p, mu, row, PC_RW_V + hc, s0, Ls);
        float wr = w0, ar = a0;
#pragma unroll 8
        for (int j = 0; j < 32; ++j) { wr += L[RL_WA + tok * 64 + j] * L[RL_W2 + j * 64 + c]; ar += L[RL_WA + tok * 64 + 32 + j] * L[RL_A2 + j * 64 + c]; }
        float decay = __expf(-0.6065306597126334f * sigmoidf_(wr)), a = sigmoidf_(ar);
        float kkr = k * k_k; float ssq = wave_sum(kkr * kkr); float kkn = kkr * rsqrtf(fmaxf(ssq, 1e-24f));
        int o = tok * 64 + c;
        L[RL_DEC + o] = decay; L[RL_KK + o] = kkn; L[RL_KKA + o] = kkn * a; L[RL_KD + o] = k * (1.f + (a - 1.f) * k_a); L[RL_R + o] = r; L[RL_V + o] = v; }
    __syncthreads();
}
__device__ __forceinline__ int rw_unit(int b, int d, int h, int j) { return ((b * 2 + d) * 4 + h) * CPB + j; }
constexpr int RW1_ITEMS = RW_UNITS;
__device__ void rw1_item(const Params& P, int l, int u, char* smem) {
    float* L = (float*)smem;
    const int j = u % CPB, h = (u / CPB) & 3, d = (u / (CPB * 4)) & 1, b = u / (CPB * 8);
    const int ch = chunk_order(b, d, j), tid = threadIdx.x, row = tid >> 2, q = tid & 3;
    __syncthreads();
    rw_load_w(P, l, d, h, L);
    float SP[16], SQ[16];
#pragma unroll
    for (int k = 0; k < 16; ++k) { SP[k] = (q * 16 + k == row) ? 1.f : 0.f; SQ[k] = 0.f; }
    for (int s2 = 0; s2 < 4; ++s2) { const int ss = d == 0 ? s2 : 3 - s2;
        rw_prep(P, l, ch, h, d, ss, L);
        for (int t2 = 0; t2 < 16; ++t2) { const int tok = d == 0 ? t2 : 15 - t2; const int o = tok * 64 + q * 16;
            float kk[16], sp = 0.f, sq = 0.f;
#pragma unroll
            for (int k4 = 0; k4 < 4; ++k4) { float4 t = *(const float4*)(L + RL_KK + o + k4 * 4); kk[k4 * 4] = t.x; kk[k4 * 4 + 1] = t.y; kk[k4 * 4 + 2] = t.z; kk[k4 * 4 + 3] = t.w; }
#pragma unroll
            for (int k = 0; k < 16; ++k) { sp += SP[k] * kk[k]; sq += SQ[k] * kk[k]; }
            sp += __shfl_xor(sp, 1); sp += __shfl_xor(sp, 2); sq += __shfl_xor(sq, 1); sq += __shfl_xor(sq, 2);
            const float vval = L[RL_V + tok * 64 + row];
#pragma unroll
            for (int k4 = 0; k4 < 4; ++k4) { float4 de = *(const float4*)(L + RL_DEC + o + k4 * 4), ka = *(const float4*)(L + RL_KKA + o + k4 * 4), kd = *(const float4*)(L + RL_KD + o + k4 * 4);
                SP[k4 * 4] = SP[k4 * 4] * de.x - sp * ka.x;         SQ[k4 * 4] = SQ[k4 * 4] * de.x - sq * ka.x + vval * kd.x;
                SP[k4 * 4 + 1] = SP[k4 * 4 + 1] * de.y - sp * ka.y; SQ[k4 * 4 + 1] = SQ[k4 * 4 + 1] * de.y - sq * ka.y + vval * kd.y;
                SP[k4 * 4 + 2] = SP[k4 * 4 + 2] * de.z - sp * ka.z; SQ[k4 * 4 + 2] = SQ[k4 * 4 + 2] * de.z - sq * ka.z + vval * kd.z;
                SP[k4 * 4 + 3] = SP[k4 * 4 + 3] * de.w - sp * ka.w; SQ[k4 * 4 + 3] = SQ[k4 * 4 + 3] * de.w - sq * ka.w + vval * kd.w; }
        }
    }
    float* rp = WSP(P, float, OFF_RP) + (size_t)u * 4096 + row * 64 + q * 16; float* rq = WSP(P, float, OFF_RQ) + (size_t)u * 4096 + row * 64 + q * 16;
#pragma unroll
    for (int k4 = 0; k4 < 4; ++k4) { *(float4*)(rp + k4 * 4) = make_float4(SP[k4 * 4], SP[k4 * 4 + 1], SP[k4 * 4 + 2], SP[k4 * 4 + 3]);
        *(float4*)(rq + k4 * 4) = make_float4(SQ[k4 * 4], SQ[k4 * 4 + 1], SQ[k4 * 4 + 2], SQ[k4 * 4 + 3]); }
}
constexpr int RW2_ITEMS = NB * 2 * 4 * 4;
__device__ void rw2_item(const Params& P, int it, char* smem) {
    const int rg = it & 3, h = (it >> 2) & 3, d = (it >> 4) & 1, b = it >> 5, tid = threadIdx.x, row = tid >> 4, cg = tid & 15;
    float* Ps = (float*)smem;
    float* Ss = Ps + 4096;
    __syncthreads();
    for (int i = tid; i < 1024; i += 256) Ss[i] = 0.f;
    float cur[4] = {0.f, 0.f, 0.f, 0.f};
    for (int j = 0; j < CPB; ++j) { const int u = rw_unit(b, d, h, j);
        const float* pg = WSP(P, float, OFF_RP) + (size_t)u * 4096; float* qg = WSP(P, float, OFF_RQ) + (size_t)u * 4096 + (rg * 16 + row) * 64 + cg * 4;
        __syncthreads();
#pragma unroll
        for (int q = 0; q < 4; ++q) { int id = tid + 256 * q; *(float4*)(Ps + id * 4) = *(const float4*)(pg + id * 4); }
        float4 qv = *(const float4*)qg;
        *(float4*)qg = make_float4(cur[0], cur[1], cur[2], cur[3]);
        __syncthreads();
        const float* sr = Ss + (j & 1) * 1024 + row * 64;
        float n0 = qv.x, n1 = qv.y, n2 = qv.z, n3 = qv.w;
#pragma unroll 8
        for (int k = 0; k < 64; ++k) { float sv = sr[k]; float4 pv = *(const float4*)(Ps + k * 64 + cg * 4); n0 += sv * pv.x; n1 += sv * pv.y; n2 += sv * pv.z; n3 += sv * pv.w; }
        cur[0] = n0; cur[1] = n1; cur[2] = n2; cur[3] = n3;
        *(float4*)(Ss + ((j + 1) & 1) * 1024 + row * 64 + cg * 4) = make_float4(n0, n1, n2, n3);
    }
}
constexpr int RW3_ITEMS = NCH * 4;
__device__ void rw3_item(const Params& P, int l, int it, char* smem) {
    float* L = (float*)smem;
    const int ch = it >> 2, h = it & 3, tid = threadIdx.x, row = tid >> 2, q = tid & 3;
    if (l == 1 && ch >= NX / 64) return;
    int b, jd0, jd1;
    if (ch < NX / 64) { b = ch / LC; int jl = ch % LC; jd0 = CC + jl; jd1 = CC + (LC - 1 - jl); }
    else { int cb = ch - NX / 64; b = cb / CC; int jc = cb % CC; jd0 = jc; jd1 = CC - 1 - jc; }
    for (int d = 0; d < 2; ++d) {
        __syncthreads();
        rw_load_w(P, l, d, h, L);
        const int u = rw_unit(b, d, h, d == 0 ? jd0 : jd1);
        float S[16];
        { const float* sg = WSP(P, float, OFF_RQ) + (size_t)u * 4096 + row * 64 + q * 16;
#pragma unroll
          for (int k4 = 0; k4 < 4; ++k4) { float4 t = *(const float4*)(sg + k4 * 4); S[k4 * 4] = t.x; S[k4 * 4 + 1] = t.y; S[k4 * 4 + 2] = t.z; S[k4 * 4 + 3] = t.w; } }
        for (int s2 = 0; s2 < 4; ++s2) { const int ss = d == 0 ? s2 : 3 - s2;
            rw_prep(P, l, ch, h, d, ss, L);
            for (int t2 = 0; t2 < 16; ++t2) { const int tok = d == 0 ? t2 : 15 - t2; const int o = tok * 64 + q * 16;
                float sa = 0.f;
#pragma unroll
                for (int k4 = 0; k4 < 4; ++k4) { float4 t = *(const float4*)(L + RL_KK + o + k4 * 4); sa += S[k4 * 4] * t.x + S[k4 * 4 + 1] * t.y + S[k4 * 4 + 2] * t.z + S[k4 * 4 + 3] * t.w; }
                sa += __shfl_xor(sa, 1); sa += __shfl_xor(sa, 2);
                const float vval = L[RL_V + tok * 64 + row];
                float y = 0.f;
#pragma unroll
                for (int k4 = 0; k4 < 4; ++k4) { float4 de = *(const float4*)(L + RL_DEC + o + k4 * 4), ka = *(const float4*)(L + RL_KKA + o + k4 * 4), kd = *(const float4*)(L + RL_KD + o + k4 * 4), rr = *(const float4*)(L + RL_R + o + k4 * 4);
                    S[k4 * 4] = S[k4 * 4] * de.x - sa * ka.x + vval * kd.x;             y += S[k4 * 4] * rr.x;
                    S[k4 * 4 + 1] = S[k4 * 4 + 1] * de.y - sa * ka.y + vval * kd.y;     y += S[k4 * 4 + 1] * rr.y;
                    S[k4 * 4 + 2] = S[k4 * 4 + 2] * de.z - sa * ka.z + vval * kd.z;     y += S[k4 * 4 + 2] * rr.z;
                    S[k4 * 4 + 3] = S[k4 * 4 + 3] * de.w - sa * ka.w + vval * kd.w;     y += S[k4 * 4 + 3] * rr.w; }
                y += __shfl_xor(y, 1); y += __shfl_xor(y, 2);
                if (q == 0) { float* yp = L + RL_Y + (ss * 16 + tok) * 64 + row; if (d == 0) *yp = y; else *yp += y; }
            }
        }
    }
    __syncthreads();
    float* gds = L;
    float* g2s = L + 4096;
    int s0, Ls; chunk_seq(ch, s0, Ls);
    const bf16_t* p = WSP(P, bf16_t, OFF_P); const float* mu = P.in[I_RMU] + (size_t)l * 960;
#pragma unroll 4
    for (int qq = 0; qq < 16; ++qq) { int id = tid + 256 * qq; int tok = id >> 6, jj = id & 63;
        gds[id] = sigmoidf_(rw_mixed(p, mu, ch * 64 + tok, PC_RW_GD + jj, s0, Ls));
        g2s[id] = P.in[I_RG2][(size_t)l * 64 * 256 + (size_t)tok * 256 + h * 64 + jj]; }
    __syncthreads();
    { const int c = tid & 63, tq = tid >> 6, hc = h * 64 + c;
      const float lnw = P.in[I_RLNW][(size_t)l * 256 + hc], lnb = P.in[I_RLNB][(size_t)l * 256 + hc], rk = P.in[I_RRK][(size_t)l * 256 + hc];
      bf16_t* out = WSP(P, bf16_t, OFF_YS) + (size_t)2 * T * 256;
      for (int tk = 0; tk < 16; ++tk) { int tok = tq * 16 + tk, rowg = ch * 64 + tok;
          float yv = L[RL_Y + tok * 64 + c];
          float mean = wave_sum(yv) * (1.0f / 64.0f); float dv = yv - mean; float var = wave_sum(dv * dv) * (1.0f / 64.0f);
          float yn = dv * rsqrtf(var + 64e-5f) * lnw + lnb;
          float r = rw_mixed(p, mu, rowg, PC_RW_R + hc, s0, Ls), k = rw_mixed(p, mu, rowg, PC_RW_K + hc, s0, Ls), v = rw_mixed(p, mu, rowg, PC_RW_V + hc, s0, Ls);
          float bonus = wave_sum(r * k * rk) * v;
          float g = 0.f;
#pragma unroll 8
          for (int j = 0; j < 64; ++j) g += gds[tok * 64 + j] * g2s[j * 64 + c];
          out[(size_t)rowg * 256 + hc] = f2bf((yn + bonus) * g); }
    }
}


constexpr int G2_ITEMS = (T / 128) * 16;
__device__ void g2_item(const Params& P, int l, int it, char* smem) {
    const int mt = it >> 4, nt = it & 15;
    if (l == 1 && mt * 128 >= NX) return;
    const bf16_t* A = WSP(P, bf16_t, OFF_XN) + (size_t)mt * 128 * D;
    bf16_t* As = (bf16_t*)smem; bf16_t* Bs = As + 128 * LDT;
    f32x4 accm[4][2]; acc_zero<2>(accm);
#pragma unroll 1
    for (int i = 0; i < 4; ++i) {
        f32x4 accg[4][2]; acc_zero<2>(accg);
        const bf16_t* Bg = WSP(P, bf16_t, OFF_WTGATE) + ((size_t)i * 1024 + nt * 64) * D;
        gemm_acc<2>(accg, D, [&](int r, int kc) { return A + (size_t)r * D + kc * 8; }, [&](int r, int kc) { return Bg + (size_t)r * D + kc * 8; }, As, Bs);
        f32x4 accb[4][2]; acc_zero<2>(accb);
        const bf16_t* Ay = WSP(P, bf16_t, OFF_YS) + ((size_t)i * T + mt * 128) * 256;
        const bf16_t* Bb = WSP(P, bf16_t, OFF_WTBR) + ((size_t)i * 1024 + nt * 64) * 256;
        gemm_acc<2>(accb, 256, [&](int r, int kc) { return Ay + (size_t)r * 256 + kc * 8; }, [&](int r, int kc) { return Bb + (size_t)r * 256 + kc * 8; }, As, Bs);
#pragma unroll
        for (int a = 0; a < 4; ++a)
#pragma unroll
            for (int b = 0; b < 2; ++b)
#pragma unroll
                for (int e = 0; e < 4; ++e) accm[a][b][e] += sigmoidf_(accg[a][b][e]) * accb[a][b][e];
    }
    bf16_t* M = WSP(P, bf16_t, OFF_MERGED) + (size_t)mt * 128 * D + nt * 64;
    gemm_epi<2>(accm, [&](int m, int n, f32x4 v) { *(uint2*)(M + (size_t)m * D + n) = make_uint2(pack2(v[0], v[1]), pack2(v[2], v[3])); });
}
constexpr int G3_ITEMS = (T / 128) * 8;
__device__ void g3_item(const Params& P, int l, int it, char* smem) {
    const int mt = it >> 3, nt = it & 7;
    if (l == 1 && mt * 128 >= NX) return;
    const bf16_t* A = WSP(P, bf16_t, OFF_MERGED) + (size_t)mt * 128 * D; const bf16_t* B = WSP(P, bf16_t, OFF_WTOUT) + (size_t)nt * 128 * D;
    bf16_t* As = (bf16_t*)smem; bf16_t* Bs = As + 128 * LDT;
    f32x4 acc[4][4]; acc_zero<4>(acc);
    gemm_acc<4>(acc, D, [&](int r, int kc) { return A + (size_t)r * D + kc * 8; }, [&](int r, int kc) { return B + (size_t)r * D + kc * 8; }, As, Bs);
    gemm_epi<4>(acc, [&](int m, int n, f32x4 v) { int row = mt * 128 + m, col = nt * 128 + n;
        const float* g1 = WSP(P, float, OFF_MODV) + ((size_t)l * NR + mod_row(row)) * 6 * D + 2 * D + col;
        float4* xp = (float4*)(res_ptr(P, row) + col); float4 x = *xp;
        x.x += g1[0] * v[0]; x.y += g1[1] * v[1]; x.z += g1[2] * v[2]; x.w += g1[3] * v[3]; *xp = x; });
}
constexpr int N2_ITEMS = T / 4;
__device__ void n2_item(const Params& P, int l, int it) {
    const int lane = threadIdx.x & 63, row = it * 4 + (threadIdx.x >> 6);
    if (l == 1 && row >= NX) return;
    const float* src = res_ptr(P, row);
    float4 v[4]; float ss = 0.f;
#pragma unroll
    for (int q = 0; q < 4; ++q) { v[q] = ((const float4*)src)[q * 64 + lane]; ss += v[q].x * v[q].x + v[q].y * v[q].y + v[q].z * v[q].z + v[q].w * v[q].w; }
    ss = wave_sum(ss);
    const float rstd = rsqrtf(ss * (1.0f / D) + 1e-6f);
    const float* g = P.in[I_NFFN] + (size_t)l * D;
    const float* mv = WSP(P, float, OFF_MODV) + ((size_t)l * NR + mod_row(row)) * 6 * D;
    const float* sh = mv + 3 * D; const float* sc = mv + 4 * D;
    bf16_t* dst = WSP(P, bf16_t, OFF_XN) + (size_t)row * D;
    const float4* wg = (const float4*)(P.in[I_MOEG] + (size_t)l * D * 4);
    const float4* we = (const float4*)(P.in[I_MOEE] + (size_t)l * 4 * D * 4);
    float lg[4] = {0.f, 0.f, 0.f, 0.f}, le[16];
#pragma unroll
    for (int i = 0; i < 16; ++i) le[i] = 0.f;
#pragma unroll
    for (int q = 0; q < 4; ++q) { int c = (q * 64 + lane) * 4;
        float4 gg = *(const float4*)(g + c), s4 = *(const float4*)(sc + c), h4 = *(const float4*)(sh + c);
        float o[4] = {v[q].x * rstd * gg.x * (1.f + s4.x) + h4.x, v[q].y * rstd * gg.y * (1.f + s4.y) + h4.y,
                      v[q].z * rstd * gg.z * (1.f + s4.z) + h4.z, v[q].w * rstd * gg.w * (1.f + s4.w) + h4.w};
        *(uint2*)(dst + c) = make_uint2(pack2(o[0], o[1]), pack2(o[2], o[3]));
#pragma unroll
        for (int e = 0; e < 4; ++e) { float4 w = wg[c + e]; lg[0] += o[e] * w.x; lg[1] += o[e] * w.y; lg[2] += o[e] * w.z; lg[3] += o[e] * w.w;
#pragma unroll
            for (int gi = 0; gi < 4; ++gi) { float4 x = we[(size_t)gi * D + c + e]; le[gi * 4] += o[e] * x.x; le[gi * 4 + 1] += o[e] * x.y; le[gi * 4 + 2] += o[e] * x.z; le[gi * 4 + 3] += o[e] * x.w; } }
    }
#pragma unroll
    for (int i = 0; i < 4; ++i) lg[i] = wave_sum(lg[i]);
#pragma unroll
    for (int i = 0; i < 16; ++i) le[i] = wave_sum(le[i]);
    int gi = 0; float gm = lg[0];
#pragma unroll
    for (int i = 1; i < 4; ++i) if (lg[i] > gm) { gm = lg[i]; gi = i; }
    float den = 0.f;
#pragma unroll
    for (int i = 0; i < 4; ++i) den += __expf(lg[i] - gm);
    const float grp_p = 1.0f / den;
    float sel[4];
#pragma unroll
    for (int i = 0; i < 4; ++i) sel[i] = gi == 0 ? le[i] : gi == 1 ? le[4 + i] : gi == 2 ? le[8 + i] : le[12 + i];
    int i1 = 0; float v1 = sel[0];
#pragma unroll
    for (int i = 1; i < 4; ++i) if (sel[i] > v1) { v1 = sel[i]; i1 = i; }
    int i2 = -1; float v2 = -3.0e38f;
#pragma unroll
    for (int i = 0; i < 4; ++i) if (i != i1 && sel[i] > v2) { v2 = sel[i]; i2 = i; }
    const float e2 = __expf(v2 - v1); const float w1 = grp_p / (1.f + e2), w2 = grp_p * e2 / (1.f + e2);
    if (lane == 0) {
        const int ea = gi * 4 + i1, eb = gi * 4 + i2;
        int* ti = WSP(P, int, OFF_TOKINFO) + (size_t)row * 4; ti[0] = ea; ti[1] = eb; ((float*)ti)[2] = w1; ((float*)ti)[3] = w2;
        int* cnt = WSP(P, int, OFF_CNT); int* list = WSP(P, int, OFF_LIST);
        int pa = atomicAdd(&cnt[ea], 1); list[(size_t)ea * T + pa] = row * 2;
        int pb = atomicAdd(&cnt[eb], 1); list[(size_t)eb * T + pb] = row * 2 + 1;
    }
}
__device__ __forceinline__ void moe_sched(const Params& P, int* sc) {
    const int* cnt = WSP(P, int, OFF_CNT); int ho = 0, ts = 0;
    for (int e = 0; e < 16; ++e) { int c = cnt[e]; sc[e] = c; sc[16 + e] = ho; sc[32 + e] = ts; ho += c; ts += ((c + 127) >> 7) * 8; }
    sc[48] = ts;
}
__device__ void e1_item(const Params& P, const int* sc, int it, char* smem) {
    int e = 0;
    while (e < 15 && it >= sc[32 + e + 1]) ++e;
    const int cnt = sc[e], hoff = sc[16 + e], r0 = it - sc[32 + e], mt = r0 >> 3, nt = r0 & 7;
    const int* list = WSP(P, int, OFF_LIST) + (size_t)e * T + mt * 128;
    const int nrow = cnt - mt * 128;
    const bf16_t* X = WSP(P, bf16_t, OFF_XN); const bf16_t* B = WSP(P, bf16_t, OFF_WTGU) + ((size_t)e * 1024 + nt * 128) * 1024;
    bf16_t* As = (bf16_t*)smem; bf16_t* Bs = As + 128 * LDT;
    f32x4 acc[4][4]; acc_zero<4>(acc);
    gemm_acc<4>(acc, D, [&](int r, int kc) -> const bf16_t* { if (r >= nrow) return nullptr; return X + (size_t)(list[r] >> 1) * D + kc * 8; },
                [&](int r, int kc) { return B + (size_t)r * 1024 + kc * 8; }, As, Bs);
    bf16_t* H = WSP(P, bf16_t, OFF_HB) + ((size_t)hoff + mt * 128) * 512 + nt * 64;
    gemm_epi<4>(acc, [&](int m, int n, f32x4 v) { if (m >= nrow) return;
        *(unsigned*)(H + (size_t)m * 512 + (n >> 1)) = pack2(siluf_(v[0]) * v[1], siluf_(v[2]) * v[3]); });
}
__device__ void e2_item(const Params& P, const int* sc, int it, char* smem) {
    int e = 0;
    while (e < 15 && it >= sc[32 + e + 1]) ++e;
    const int cnt = sc[e], hoff = sc[16 + e], r0 = it - sc[32 + e], mt = r0 >> 3, nt = r0 & 7;
    const int* list = WSP(P, int, OFF_LIST) + (size_t)e * T + mt * 128;
    const int nrow = cnt - mt * 128;
    const bf16_t* H = WSP(P, bf16_t, OFF_HB) + ((size_t)hoff + mt * 128) * 512; const bf16_t* B = WSP(P, bf16_t, OFF_WTDN) + ((size_t)e * 1024 + nt * 128) * 512;
    bf16_t* As = (bf16_t*)smem; bf16_t* Bs = As + 128 * LDT;
    f32x4 acc[4][4]; acc_zero<4>(acc);
    gemm_acc<4>(acc, 512, [&](int r, int kc) -> const bf16_t* { if (r >= nrow) return nullptr; return H + (size_t)r * 512 + kc * 8; },
                [&](int r, int kc) { return B + (size_t)r * 512 + kc * 8; }, As, Bs);
    bf16_t* Y2 = WSP(P, bf16_t, OFF_Y2);
    gemm_epi<4>(acc, [&](int m, int n, f32x4 v) { if (m >= nrow) return;
        int ent = list[m], tok = ent >> 1, slot = ent & 1;
        float w = WSP(P, float, OFF_TOKINFO)[(size_t)tok * 4 + 2 + slot];
        *(uint2*)(Y2 + ((size_t)slot * T + tok) * D + nt * 128 + n) = make_uint2(pack2(w * v[0], w * v[1]), pack2(w * v[2], w * v[3])); });
}
constexpr int R_ITEMS = T / 4;
__device__ void r_item(const Params& P, int l, int it) {
    const int lane = threadIdx.x & 63, row = it * 4 + (threadIdx.x >> 6);
    if (l == 1 && row >= NX) return;
    float* res = res_ptr(P, row);
    const float* g2 = WSP(P, float, OFF_MODV) + ((size_t)l * NR + mod_row(row)) * 6 * D + 5 * D;
    const bf16_t* ya = WSP(P, bf16_t, OFF_Y2) + (size_t)row * D; const bf16_t* yb = ya + (size_t)T * D;
    float4 v[4]; float ss = 0.f;
#pragma unroll
    for (int q = 0; q < 4; ++q) { int c = (q * 64 + lane) * 4;
        float4 x = *(const float4*)(res + c), gg = *(const float4*)(g2 + c);
        uint2 a = *(const uint2*)(ya + c), b = *(const uint2*)(yb + c);
        x.x += gg.x * (u2f(a.x << 16) + u2f(b.x << 16)); x.y += gg.y * (u2f(a.x & 0xffff0000u) + u2f(b.x & 0xffff0000u));
        x.z += gg.z * (u2f(a.y << 16) + u2f(b.y << 16)); x.w += gg.w * (u2f(a.y & 0xffff0000u) + u2f(b.y & 0xffff0000u));
        v[q] = x; ss += x.x * x.x + x.y * x.y + x.z * x.z + x.w * x.w; }
    ss = wave_sum(ss);
    const float rstd = rsqrtf(ss * (1.0f / D) + 1e-6f);
    if (l == 0) {
        const float* g = P.in[I_NMIX] + (size_t)1 * D;
        const float* mv = WSP(P, float, OFF_MODV) + ((size_t)1 * NR + mod_row(row)) * 6 * D;
        bf16_t* dst = WSP(P, bf16_t, OFF_XN) + (size_t)row * D;
#pragma unroll
        for (int q = 0; q < 4; ++q) { int c = (q * 64 + lane) * 4;
            *(float4*)(res + c) = v[q];
            float4 gg = *(const float4*)(g + c), s4 = *(const float4*)(mv + D + c), h4 = *(const float4*)(mv + c);
            *(uint2*)(dst + c) = make_uint2(pack2(v[q].x * rstd * gg.x * (1.f + s4.x) + h4.x, v[q].y * rstd * gg.y * (1.f + s4.y) + h4.y),
                                            pack2(v[q].z * rstd * gg.z * (1.f + s4.z) + h4.z, v[q].w * rstd * gg.w * (1.f + s4.w) + h4.w)); }
    } else {
        const float* g = P.in[I_NFIN];
#pragma unroll
        for (int q = 0; q < 4; ++q) { int c = (q * 64 + lane) * 4; float4 gg = *(const float4*)(g + c);
            *(float4*)(res + c) = make_float4(v[q].x * rstd * gg.x, v[q].y * rstd * gg.y, v[q].z * rstd * gg.z, v[q].w * rstd * gg.w); }
    }
}

enum { PH_P0A = 0, PH_P0B = 1, PH_LAYER0 = 2, PHL_G1 = 0, PHL_M1, PHL_M2, PHL_M3, PHL_M4, PHL_G2, PHL_G3, PHL_N2, PHL_E1, PHL_E2, PHL_R, PHL_COUNT,
       NPHASES = PH_LAYER0 + 2 * PHL_COUNT };

struct ItemCursor {
    int rot;
    __device__ ItemCursor() : rot(0) {}
};
#define FOR_ITEMS(cur, N, it) for (int it = (int)((blockIdx.x + gridDim.x - ((cur).rot % gridDim.x)) % gridDim.x), _n = (N), _once = ((cur).rot += _n, 0); it < _n; it += gridDim.x)

__device__ void prep_a_items(const Params& P, int l, ItemCursor& cur, char* smem) {
    FOR_ITEMS(cur, CV_MAIN, it) conv_main_item(P, l, it, smem);
    FOR_ITEMS(cur, H2_ITEMS, it) hy_h2_item(P, l, it, smem);
    FOR_ITEMS(cur, S5E_ITEMS, it) s5e_item(P, l, it);
    FOR_ITEMS(cur, S5BB_ITEMS, it) s5bb_item(P, l, it);
}
__device__ void prep_b_items(const Params& P, int l, ItemCursor& cur, char* smem) {
    FOR_ITEMS(cur, HSPEC_ITEMS, it) hspec_item(P, l, it, smem);
    FOR_ITEMS(cur, S5KC_ITEMS, it) s5kc_item(P, l, it);
    FOR_ITEMS(cur, S5PM_ITEMS, it) s5pm_item(P, it);
    FOR_ITEMS(cur, S5RM_ITEMS, it) s5rm_item(P, l, it);
}

template <int KIND>
__device__ __forceinline__ void run_kind(const Params& P, int l, char* smem) {
    ItemCursor cur;
    if constexpr (KIND == 0) {
        FOR_ITEMS(cur, MODV_ITEMS, it) modv_item(P, it, smem);
        FOR_ITEMS(cur, TW_ITEMS, it) tw_item(P, it);
        FOR_ITEMS(cur, COPY_ITEMS, it) copy_item(P, it);
        prep_a_items(P, 0, cur, smem);
    } else if constexpr (KIND == 1) {
        prep_b_items(P, 0, cur, smem);
        FOR_ITEMS(cur, NORM_ITEMS, it) norm_item(P, 0, 0, true, it);
    } else if constexpr (KIND == 2 + PHL_G1) {
        if (blockIdx.x == 0 && threadIdx.x < 16) WSP(P, int, OFF_CNT)[threadIdx.x] = 0;
        FOR_ITEMS(cur, G1_ITEMS, it) g1_item(P, l, it, smem);
    } else if constexpr (KIND == 2 + PHL_M1) {
        FOR_ITEMS(cur, RW1_ITEMS, it) rw1_item(P, l, it, smem);
        FOR_ITEMS(cur, S5A_ITEMS, it) s5a_item(P, it, smem);
        FOR_ITEMS(cur, M2A_ITEMS, it) m2a_item(P, l, it, smem);
        FOR_ITEMS(cur, HY1_ITEMS, it) hy1_item(P, l, it, smem);
    } else if constexpr (KIND == 2 + PHL_M2) {
        FOR_ITEMS(cur, RW2_ITEMS, it) rw2_item(P, it, smem);
        FOR_ITEMS(cur, HY2_ITEMS, it) hy2_item(P, l, it, smem);
        FOR_ITEMS(cur, S5B_ITEMS, it) s5b_item(P, it);
        FOR_ITEMS(cur, M2B_ITEMS, it) m2b_item(P, it);
    } else if constexpr (KIND == 2 + PHL_M3) {
        FOR_ITEMS(cur, RW3_ITEMS, it) rw3_item(P, l, it, smem);
        FOR_ITEMS(cur, S5C_ITEMS, it) s5c_item(P, l, it, smem);
        FOR_ITEMS(cur, M2C_ITEMS, it) m2c_item(P, l, it, smem);
        FOR_ITEMS(cur, HY3_ITEMS, it) hy3_item(P, l, it, smem);
    } else if constexpr (KIND == 2 + PHL_M4) {
        FOR_ITEMS(cur, S5D_ITEMS, it) s5d_item(P, it, smem);
        FOR_ITEMS(cur, CV_MOE, it) conv_moe_item(P, l, it, smem);
    } else if constexpr (KIND == 2 + PHL_G2) {
        FOR_ITEMS(cur, G2_ITEMS, it) g2_item(P, l, it, smem);
    } else if constexpr (KIND == 2 + PHL_G3) {
        FOR_ITEMS(cur, G3_ITEMS, it) g3_item(P, l, it, smem);
    } else if constexpr (KIND == 2 + PHL_N2) {
        FOR_ITEMS(cur, N2_ITEMS, it) n2_item(P, l, it);
    } else if constexpr (KIND == 2 + PHL_E1 || KIND == 2 + PHL_E2) {
        int* sc = (int*)(smem + 65536);
        __syncthreads();
        if (threadIdx.x == 0) moe_sched(P, sc);
        __syncthreads();
        const int ntile = sc[48];
        if constexpr (KIND == 2 + PHL_E1) { FOR_ITEMS(cur, ntile, it) e1_item(P, sc, it, smem); if (l == 0) prep_a_items(P, 1, cur, smem); }
        else { FOR_ITEMS(cur, ntile, it) e2_item(P, sc, it, smem); if (l == 0) prep_b_items(P, 1, cur, smem); }
    } else if constexpr (KIND == 2 + PHL_R) {
        FOR_ITEMS(cur, R_ITEMS, it) r_item(P, l, it);
    }
}
constexpr int NKINDS = 2 + PHL_COUNT;
__device__ void run_phase(const Params& P, int ph, char* smem) {
    const int kind = ph < 2 ? ph : 2 + (ph - PH_LAYER0) % PHL_COUNT, l = ph < 2 ? 0 : (ph - PH_LAYER0) / PHL_COUNT;
    switch (kind) {
    case 0: run_kind<0>(P, l, smem); break;   case 1: run_kind<1>(P, l, smem); break;   case 2: run_kind<2>(P, l, smem); break;
    case 3: run_kind<3>(P, l, smem); break;   case 4: run_kind<4>(P, l, smem); break;   case 5: run_kind<5>(P, l, smem); break;
    case 6: run_kind<6>(P, l, smem); break;   case 7: run_kind<7>(P, l, smem); break;   case 8: run_kind<8>(P, l, smem); break;
    case 9: run_kind<9>(P, l, smem); break;   case 10: run_kind<10>(P, l, smem); break; case 11: run_kind<11>(P, l, smem); break;
    case 12: run_kind<12>(P, l, smem); break;
    }
}

template <int KIND>
__global__ void __launch_bounds__(NTHREADS, 2) k_phase(Params P, int l) {
    __shared__ __attribute__((aligned(16))) char smem[SMEM_BYTES];
    run_kind<KIND>(P, l, smem);
}

#ifdef CPU_EMU
static int emu_stop_after = 1000000;
#define EMU_OUT_SIZE (NX * D)
#define EMU_WS_BYTES WS_TOTAL
static void emu_dump_layout(const char* dir) {
    char path[512]; snprintf(path, sizeof path, "%s/layout.txt", dir); FILE* f = fopen(path, "w");
#define LAY(n) fprintf(f, #n " %zu\n", (size_t)n);
    LAY(OFF_MODV) LAY(OFF_TW) LAY(OFF_CRES) LAY(OFF_XN) LAY(OFF_YS) LAY(OFF_WTIN) LAY(OFF_WTGATE) LAY(OFF_WTBR) LAY(OFF_WTOUT) LAY(OFF_WTGLU)
    LAY(OFF_UT) LAY(OFF_HSPEC) LAY(OFF_UTC) LAY(OFF_FC) LAY(OFF_H2) LAY(OFF_MERGED) LAY(OFF_S5E) LAY(OFF_S5BB) LAY(OFF_S5KC) LAY(OFF_S5PM) LAY(OFF_S5RM)
    LAY(OFF_S5ST) LAY(OFF_S5XE) LAY(OFF_S5Y1) LAY(OFF_MST) LAY(OFF_MCD) LAY(OFF_RP) LAY(OFF_RQ) LAY(OFF_Y2) LAY(OFF_P) LAY(OFF_WTGU) LAY(OFF_WTDN) LAY(OFF_HB)
    LAY(OFF_CNT) LAY(OFF_LIST) LAY(OFF_TOKINFO) LAY(WS_TOTAL) LAY(T) LAY(NX) LAY(NC) LAY(NB) LAY(SEQ) LAY(CTX) LAY(NP) LAY(NCH) LAY(NCHP) LAY(NR) LAY(FFTN) LAY(RW_UNITS)
    fclose(f);
}
#endif

extern "C" void kernel_launch(void* const* d_in, const int* in_sizes, int n_in, void* d_out, int out_size, void* d_ws, size_t ws_size, hipStream_t stream) {
    Params P{};
    for (int i = 0; i < N_IN; ++i) P.in[i] = (const float*)d_in[i];
    P.out = (float*)d_out; P.ws = (char*)d_ws;
#ifdef CPU_EMU
    int grid = 16;
    for (int ph = 0; ph < NPHASES && ph <= emu_stop_after; ++ph) {
        fprintf(stderr, "phase %d\n", ph);
        emu_launch([=]() { __shared__ __attribute__((aligned(16))) char smem[SMEM_BYTES]; run_phase(P, ph, smem); }, dim3(grid), dim3(NTHREADS));
    }
#else
    const int grid = 512;
#define LK(K, L_) k_phase<K><<<grid, NTHREADS, 0, stream>>>(P, L_)
    LK(0, 0); LK(1, 0);
    for (int l = 0; l < 2; ++l) { LK(2, l); LK(3, l); LK(4, l); LK(5, l); LK(6, l); LK(7, l); LK(8, l); LK(9, l); LK(10, l); LK(11, l); LK(12, l); }
#undef LK
#endif
}
```
